# Optimizing an MI355X kernel written in HIP

```python
import math
import jax, jax.numpy as jnp
from jax import lax
import numpy as np

D_MODEL = 1024
BATCH = 8
SEQ = 2048
DEPTH = 4

HEAD_DIM = 64
D_MIX = D_MODEL
A_HEADS = (3 * D_MIX) // (8 * HEAD_DIM)
A_WIDTH = A_HEADS * HEAD_DIM
IDX_HEADS = 4
IDX_DIM = HEAD_DIM
DSA_TOPK_MAX = 256
B_HEADS = D_MIX // (4 * HEAD_DIM)
B_QK_DIM = HEAD_DIM // 2
B_WIDTH = B_HEADS * HEAD_DIM
SUBLN_EPS = 1e-5
C_HEADS = A_HEADS
C_WIDTH = C_HEADS * HEAD_DIM
MOBA_BLOCK = 256
MOBA_TOPK = 3
ROPE_THETA = 500000.0
ROPE_FRACTION = 4
MAX_POS_OFFSET = 1024
Q_BLOCK = 128
MOBA_Q_BLOCK = 32
D_FF = 2816
N_EXPERTS = 8
TOP_K_EXPERTS = 2
D_FF_EXPERT = 2816
EPS = 1e-6
IN_COLS = (A_WIDTH, HEAD_DIM, HEAD_DIM, IDX_HEADS * IDX_DIM, IDX_DIM, IDX_HEADS,
           2 * B_HEADS * B_QK_DIM, 2 * B_HEADS * B_QK_DIM, B_WIDTH,
           C_WIDTH, C_WIDTH, C_WIDTH)
D_IN = sum(IN_COLS)

kernel_name = 'hybrid_dsa_diff_moba_moe_adaln'

F32 = jnp.float32


def _split_points():
    pts, acc = [], 0
    for w in IN_COLS[:-1]:
        acc += w
        pts.append(acc)
    return pts


def rms_norm(x, g, eps=EPS):
    xf = x.astype(F32)
    y = xf * lax.rsqrt(jnp.mean(xf * xf, axis=-1, keepdims=True) + eps)
    return (y * g.astype(F32)).astype(x.dtype)


def rope_tables(positions, dim):
    rot = dim // ROPE_FRACTION
    inv = 1.0 / (ROPE_THETA ** (np.arange(0, rot, 2, dtype=np.float32) / rot))
    ang = positions.astype(F32)[..., None] * jnp.asarray(inv, F32)
    return jnp.cos(ang), jnp.sin(ang)


def partial_rope(x, cos, sin):
    half = cos.shape[-1]
    xf = x.astype(F32)
    x1, x2, xp = xf[..., :half], xf[..., half:2 * half], xf[..., 2 * half:]
    c, s = cos[:, :, None, :], sin[:, :, None, :]
    return jnp.concatenate([x1 * c - x2 * s, x2 * c + x1 * s, xp], axis=-1).astype(x.dtype)


def dsa_attention(q, k, v, q_idx, k_idx, w_idx):
    B, S, H, dh = q.shape
    k_top = min(DSA_TOPK_MAX, S // 4)
    key_pos = jnp.arange(S)
    kf_idx = k_idx.astype(F32)
    gather = jax.vmap(lambda zz, ii: zz[ii])

    def one_block(i):
        t0 = i * Q_BLOCK
        t = t0 + jnp.arange(Q_BLOCK)
        qb = lax.dynamic_slice_in_dim(q, t0, Q_BLOCK, axis=1).astype(F32)
        qib = lax.dynamic_slice_in_dim(q_idx, t0, Q_BLOCK, axis=1).astype(F32)
        wb = lax.dynamic_slice_in_dim(w_idx, t0, Q_BLOCK, axis=1).astype(F32) * IDX_HEADS ** -0.5
        rel = jax.nn.relu(jnp.einsum('bqhd,bsd->bqhs', qib, kf_idx) * IDX_DIM ** -0.5)
        score_idx = jnp.einsum('bqh,bqhs->bqs', wb, rel)
        causal = key_pos[None, :] <= t[:, None]
        score_idx = jnp.where(causal[None], score_idx, -jnp.inf)
        _, sel = lax.top_k(score_idx, k_top)
        valid = sel <= t[None, :, None]
        kg = gather(k, sel).astype(F32)
        vg = gather(v, sel).astype(F32)
        s = jnp.einsum('bqhd,bqkd->bqhk', qb, kg) * dh ** -0.5
        s = jnp.where(valid[:, :, None, :], s, -jnp.inf)
        p = jax.nn.softmax(s, axis=-1)
        return jnp.einsum('bqhk,bqkd->bqhd', p, vg).astype(q.dtype)

    out = lax.map(one_block, jnp.arange(S // Q_BLOCK))
    return jnp.moveaxis(out, 0, 1).reshape(B, S, H * dh)


def diff_attention(q, k, v, lam, g_sub, lam_init):
    B, S, H, _, dq = q.shape
    dv = v.shape[-1]
    key_pos = jnp.arange(S)
    kf = k.astype(F32)
    vf = v.astype(F32)

    def one_block(i):
        t0 = i * Q_BLOCK
        t = t0 + jnp.arange(Q_BLOCK)
        qb = lax.dynamic_slice_in_dim(q, t0, Q_BLOCK, axis=1).astype(F32)
        s = jnp.einsum('bqhcd,bshcd->bhcqs', qb, kf) * dq ** -0.5
        causal = key_pos[None, :] <= t[:, None]
        p = jax.nn.softmax(jnp.where(causal, s, -jnp.inf), axis=-1)
        a = p[:, :, 0] - lam * p[:, :, 1]
        return jnp.einsum('bhqs,bshd->bqhd', a, vf)

    o = lax.map(one_block, jnp.arange(S // Q_BLOCK))
    o = jnp.moveaxis(o, 0, 1).reshape(B, S, H, dv)
    o = rms_norm(o, g_sub, SUBLN_EPS) * (1.0 - lam_init)
    return o.reshape(B, S, H * dv).astype(v.dtype)


def moba_attention(q, k, v):
    B, S, H, dh = q.shape
    nb = -(-S // MOBA_BLOCK)
    n_sel = min(MOBA_TOPK, nb - 1)
    pad = nb * MOBA_BLOCK - S

    def to_blocks(z):
        z = jnp.pad(z, ((0, 0), (0, pad), (0, 0), (0, 0)))
        return z.reshape(B, nb, MOBA_BLOCK, H, dh).transpose(0, 3, 1, 2, 4)

    kb = to_blocks(k)
    vb = to_blocks(v)
    k_mean = jnp.mean(kb.astype(F32), axis=3)
    qh = q.transpose(0, 2, 1, 3)
    scale = dh ** -0.5
    in_block = jnp.arange(MOBA_BLOCK)
    gather = jax.vmap(jax.vmap(lambda zz, ii: zz[ii]))

    def one_block(i):
        t0 = i * MOBA_Q_BLOCK
        t = t0 + jnp.arange(MOBA_Q_BLOCK)
        own = t0 // MOBA_BLOCK
        qb = lax.dynamic_slice_in_dim(qh, t0, MOBA_Q_BLOCK, axis=2).astype(F32)
        k_own = lax.dynamic_index_in_dim(kb, own, axis=2, keepdims=False).astype(F32)
        v_own = lax.dynamic_index_in_dim(vb, own, axis=2, keepdims=False).astype(F32)
        s_own = jnp.einsum('bhqd,bhkd->bhqk', qb, k_own) * scale
        s_own = jnp.where((own * MOBA_BLOCK + in_block)[None, :] <= t[:, None], s_own, -jnp.inf)
        if n_sel == 0:
            p_own = jax.nn.softmax(s_own, axis=-1)
            return jnp.einsum('bhqk,bhkd->bhqd', p_own, v_own).astype(q.dtype)
        n_past = t // MOBA_BLOCK
        gate = jnp.einsum('bhqd,bhnd->bhqn', qb, k_mean)
        gate = jnp.where(jnp.arange(nb)[None, :] < n_past[:, None], gate, -jnp.inf)
        _, sel = lax.top_k(gate, n_sel)
        kg = gather(kb, sel).astype(F32)
        vg = gather(vb, sel).astype(F32)
        s_sel = jnp.einsum('bhqd,bhqnkd->bhqnk', qb, kg) * scale
        sel_ok = jnp.arange(n_sel)[None, :] < n_past[:, None]
        s_sel = jnp.where(sel_ok[None, None, :, :, None], s_sel, -jnp.inf)
        n_keys = n_sel * MOBA_BLOCK
        s_all = jnp.concatenate([s_sel.reshape(B, H, MOBA_Q_BLOCK, n_keys), s_own], axis=-1)
        p = jax.nn.softmax(s_all, axis=-1)
        p_sel = p[..., :n_keys].reshape(B, H, MOBA_Q_BLOCK, n_sel, MOBA_BLOCK)
        p_own = p[..., n_keys:]
        o = jnp.einsum('bhqnk,bhqnkd->bhqd', p_sel, vg) + jnp.einsum('bhqk,bhkd->bhqd', p_own, v_own)
        return o.astype(q.dtype)

    out = lax.map(one_block, jnp.arange(S // MOBA_Q_BLOCK))
    return out.transpose(1, 0, 3, 2, 4).reshape(B, S, H * dh)


def hybrid_mixer(h, cos64, sin64, cos32, sin32, w_in, w_out, lam_vec, g_sub, lam_init):
    B, S, _ = h.shape
    proj = jnp.einsum('bsd,dn->bsn', h, w_in)
    (q_a, k_a, v_a, q_i, k_i, w_i, q_b, k_b, v_b, q_c, k_c, v_c) = jnp.split(proj, _split_points(), axis=-1)
    q_a = partial_rope(q_a.reshape(B, S, A_HEADS, HEAD_DIM), cos64, sin64)
    k_a = partial_rope(k_a.reshape(B, S, 1, HEAD_DIM), cos64, sin64)[:, :, 0]
    q_i = partial_rope(q_i.reshape(B, S, IDX_HEADS, IDX_DIM), cos64, sin64)
    k_i = partial_rope(k_i.reshape(B, S, 1, IDX_DIM), cos64, sin64)[:, :, 0]
    y_a = dsa_attention(q_a, k_a, v_a, q_i, k_i, w_i)
    q_b = partial_rope(q_b.reshape(B, S, 2 * B_HEADS, B_QK_DIM), cos32, sin32).reshape(B, S, B_HEADS, 2, B_QK_DIM)
    k_b = partial_rope(k_b.reshape(B, S, 2 * B_HEADS, B_QK_DIM), cos32, sin32).reshape(B, S, B_HEADS, 2, B_QK_DIM)
    v_b = v_b.reshape(B, S, B_HEADS, HEAD_DIM)
    lf = lam_vec.astype(F32)
    lam = jnp.exp(jnp.sum(lf[0] * lf[1])) - jnp.exp(jnp.sum(lf[2] * lf[3])) + lam_init
    y_b = diff_attention(q_b, k_b, v_b, lam, g_sub, lam_init)
    q_c = partial_rope(q_c.reshape(B, S, C_HEADS, HEAD_DIM), cos64, sin64)
    k_c = partial_rope(k_c.reshape(B, S, C_HEADS, HEAD_DIM), cos64, sin64)
    y_c = moba_attention(q_c, k_c, v_c.reshape(B, S, C_HEADS, HEAD_DIM))
    y = jnp.concatenate([y_a, y_b, y_c], axis=-1)
    return jnp.einsum('bsm,md->bsd', y, w_out)


def swiglu(h, w_gate, w_up, w_down):
    a = jnp.einsum('bsd,df->bsf', h, w_gate)
    u = jnp.einsum('bsd,df->bsf', h, w_up)
    return jnp.einsum('bsf,fd->bsd', jax.nn.silu(a) * u, w_down)


def moe_swiglu(h, w_router, w_gate, w_up, w_down):
    logits = jnp.einsum('bsd,de->bse', h.astype(F32), w_router.astype(F32))
    top_val, top_idx = lax.top_k(logits, TOP_K_EXPERTS)
    top_w = jax.nn.softmax(top_val, axis=-1)
    combine = jnp.sum(jax.nn.one_hot(top_idx, N_EXPERTS, dtype=F32) * top_w[..., None], axis=-2)
    out = jnp.zeros_like(h)
    for e in range(N_EXPERTS):
        out = out + combine[..., e:e + 1].astype(h.dtype) * swiglu(h, w_gate[e], w_up[e], w_down[e])
    return out


def setup_inputs(seed: int = 0) -> dict:
    key = jax.random.key(seed)
    ks = jax.random.split(key, 20)
    n_dense = (DEPTH + 1) // 2
    n_moe = DEPTH // 2

    def nrm(k, shape, scale):
        return jax.random.normal(k, shape, F32) * scale

    x = nrm(ks[0], (BATCH, SEQ, D_MODEL), 1.0)
    c = nrm(ks[1], (BATCH, D_MODEL), 1.0)
    offset = jax.random.randint(ks[2], (BATCH, 1), 0, MAX_POS_OFFSET, dtype=jnp.int32)
    positions = offset + jnp.arange(SEQ, dtype=jnp.int32)[None, :]
    w_in = nrm(ks[3], (DEPTH, D_MODEL, D_IN), D_MODEL ** -0.5)
    w_out = nrm(ks[4], (DEPTH, D_MIX, D_MODEL), D_MIX ** -0.5)
    diff_lambda = nrm(ks[5], (DEPTH, 4, B_QK_DIM), 0.1)
    diff_subln = 1.0 + nrm(ks[6], (DEPTH, HEAD_DIM), 0.01)
    w_ada = nrm(ks[7], (DEPTH, D_MODEL, 6 * D_MODEL), 0.5 * D_MODEL ** -0.5)
    b_ada = nrm(ks[8], (DEPTH, 6 * D_MODEL), 0.01)
    g_attn = 1.0 + nrm(ks[9], (DEPTH, D_MODEL), 0.01)
    g_ffn = 1.0 + nrm(ks[10], (DEPTH, D_MODEL), 0.01)
    w_ff_gate = nrm(ks[11], (n_dense, D_MODEL, D_FF), D_MODEL ** -0.5)
    w_ff_up = nrm(ks[12], (n_dense, D_MODEL, D_FF), D_MODEL ** -0.5)
    w_ff_down = nrm(ks[13], (n_dense, D_FF, D_MODEL), D_FF ** -0.5)
    w_router = nrm(ks[14], (n_moe, D_MODEL, N_EXPERTS), D_MODEL ** -0.5)
    w_exp_gate = nrm(ks[15], (n_moe, N_EXPERTS, D_MODEL, D_FF_EXPERT), D_MODEL ** -0.5)
    w_exp_up = nrm(ks[16], (n_moe, N_EXPERTS, D_MODEL, D_FF_EXPERT), D_MODEL ** -0.5)
    w_exp_down = nrm(ks[17], (n_moe, N_EXPERTS, D_FF_EXPERT, D_MODEL), D_FF_EXPERT ** -0.5)
    g_final = 1.0 + nrm(ks[18], (D_MODEL,), 0.01)
    return {'x': x, 'c': c, 'positions': positions, 'w_in': w_in, 'w_out': w_out,
            'diff_lambda': diff_lambda, 'diff_subln': diff_subln, 'w_ada': w_ada, 'b_ada': b_ada,
            'g_attn': g_attn, 'g_ffn': g_ffn, 'w_ff_gate': w_ff_gate, 'w_ff_up': w_ff_up,
            'w_ff_down': w_ff_down, 'w_router': w_router, 'w_exp_gate': w_exp_gate,
            'w_exp_up': w_exp_up, 'w_exp_down': w_exp_down, 'g_final': g_final}


def reference(x, c, positions, w_in, w_out, diff_lambda, diff_subln, w_ada, b_ada,
              g_attn, g_ffn, w_ff_gate, w_ff_up, w_ff_down, w_router, w_exp_gate,
              w_exp_up, w_exp_down, g_final):
    cos64, sin64 = rope_tables(positions, HEAD_DIM)
    cos32, sin32 = rope_tables(positions, B_QK_DIM)
    c_act = jax.nn.silu(c)
    for layer in range(DEPTH):
        mod = jnp.einsum('bd,dn->bn', c_act, w_ada[layer]) + b_ada[layer]
        sh1, sc1, gt1, sh2, sc2, gt2 = [m[:, None, :] for m in jnp.split(mod, 6, axis=-1)]
        lam_init = 0.8 - 0.6 * math.exp(-0.3 * layer)
        h = rms_norm(x, g_attn[layer]) * (1.0 + sc1) + sh1
        y = hybrid_mixer(h, cos64, sin64, cos32, sin32, w_in[layer], w_out[layer],
                         diff_lambda[layer], diff_subln[layer], lam_init)
        x = x + gt1 * y
        h = rms_norm(x, g_ffn[layer]) * (1.0 + sc2) + sh2
        j = layer // 2
        if layer % 2 == 0:
            f = swiglu(h, w_ff_gate[j], w_ff_up[j], w_ff_down[j])
        else:
            f = moe_swiglu(h, w_router[j], w_exp_gate[j], w_exp_up[j], w_exp_down[j])
        x = x + gt2 * f
    return rms_norm(x, g_final)
```

```cpp
#include <hip/hip_runtime.h>
#include <cstdio>
#include <cstdint>
#include <cmath>
namespace pg8 {
#define PG8_LAS __attribute__((address_space(3)))
typedef unsigned short bf16_t;
typedef short bf16x8 __attribute__((ext_vector_type(8)));
typedef float f32x4 __attribute__((ext_vector_type(4)));
typedef unsigned u32x4 __attribute__((ext_vector_type(4)));
constexpr int BM = 256, BK = 64, HALF = 128, HTB = HALF * BK * 2  , STAGE_BYTES = 8 * HTB, NXCD = 8, WGM = 8;

__host__ __device__ __forceinline__ int lds_byte(int r, int c) { const int st = (r >> 4) * 2 + (c >> 5), rr = r & 15, cc = c & 31, ob = rr * 64 + cc * 2; return st * 1024 + (ob ^ (((ob >> 9) & 1) << 5)); }
__host__ __device__ __forceinline__ void stage_rc(int b, int& R, int& C) { const int st = b / 1024, sb = b % 1024, swz = sb ^ (((sb >> 9) & 1) << 5); R = (st >> 1) * 16 + swz / 64; C = (st & 1) * 32 + (swz % 64) / 2; }
__host__ __device__ __forceinline__ int perm32(int rho) { const int n = rho >> 4, i = rho & 15; return 8 * (i >> 2) + 4 * n + (i & 3); }

struct Unit { int pm, pn; };
struct Gemm { const bf16_t* A; const bf16_t* Bt; int M, N, K; };

struct StaticOrder {
    int nM, nN, nwg, G, c;
    __host__ __device__ void init(int M, int N, int G_, int c_) { nM = M / BM; nN = N / BM; nwg = nM * nN; G = G_; c = c_; }
    __host__ __device__ bool next(int i, Unit& u) const {
        const long L = (long)i * G + c; if (L >= nwg) return false;
        int wgid = (int)L; { const int q = nwg / NXCD, r = nwg % NXCD, xcd = wgid % NXCD, off = wgid / NXCD; wgid = (xcd < r ? xcd * (q + 1) : r * (q + 1) + (xcd - r) * q) + off; }
        const int nig = WGM * nN, gid = wgid / nig, fm = gid * WGM, gsz = (nM - fm) < WGM ? (nM - fm) : WGM;
        u.pm = fm + ((wgid % nig) % gsz); u.pn = (wgid % nig) / gsz; return true;
    }
    __device__ __forceinline__ void a_ready(const Unit&) const {}
    __device__ __forceinline__ void done(const Unit&) const {}
};

__device__ __forceinline__ unsigned cvt_pk_bf16(float lo, float hi) { unsigned r; asm volatile("v_cvt_pk_bf16_f32 %0, %1, %2" : "=v"(r) : "v"(lo), "v"(hi)); return r; }
typedef float f32x2 __attribute__((ext_vector_type(2)));
typedef int v8i32 __attribute__((ext_vector_type(8)));
typedef int v4i32 __attribute__((ext_vector_type(4)));
__device__ __forceinline__ v8i32 cat8(bf16x8 a, bf16x8 b) { const v4i32 x = __builtin_bit_cast(v4i32, a), y = __builtin_bit_cast(v4i32, b); return (v8i32){x[0], x[1], x[2], x[3], y[0], y[1], y[2], y[3]}; }
template <class Epi, class Sched, bool ALIGN_EPI = false, bool SP2 = false, bool F8 = false>
__device__ __forceinline__ void gemm_phase(PG8_LAS unsigned char* lds, const Gemm g, const Sched& S, const Epi& E, int tid_in) {
    int tid_l = tid_in; asm volatile("" : "+v"(tid_l));
    const int tid = tid_l, wid = __builtin_amdgcn_readfirstlane(tid >> 6), lane = tid & 63, wr = wid >> 2, wc = wid & 3, fr = lane & 15, fq = lane >> 4;
    const int K = g.K, nt = K / BK;
    unsigned voffA[2], voffB[2];
#pragma unroll
    for (int i = 0; i < 2; ++i) { int R, C; stage_rc(tid * 16 + i * 8192, R, C); const int Rb = Epi::PERM ? ((R & ~31) + perm32(R & 31)) : R;
        voffA[i] = (unsigned)(R * K + C) * 2u; voffB[i] = (unsigned)(Rb * K + C) * 2u; }
    const size_t kstep = (size_t)(BK * 2);
    const size_t hstep = (size_t)HALF * K * 2;
    const size_t tstep = 2 * hstep;
    const unsigned ldsw = (unsigned)wid * 1024u;
    const int aoff = lds_byte(wr * 64 + fr, fq * 8), boff = lds_byte(wc * 32 + fr, fq * 8);
#define PG8_SA(b, h) (((b) * 2 + (h)) * HTB)
#define PG8_SB(b, h) ((4 + (b) * 2 + (h)) * HTB)
#define PG8_STAGE(bufoff, gbase, voff) do { _Pragma("unroll") for (int _i = 0; _i < 2; ++_i) \
        __builtin_amdgcn_global_load_lds((const unsigned*)((const char*)(gbase) + (voff)[_i]), (PG8_LAS unsigned*)(lds + (bufoff) + ldsw + _i * 8192), 16, 0, 0); } while (0)
#define PG8_LDA(dst, b, h) do { _Pragma("unroll") for (int m = 0; m < 4; ++m) { const bf16x8 x0_ = *(const PG8_LAS bf16x8*)(lds + PG8_SA(b, h) + aoff + m * 2048), x1_ = *(const PG8_LAS bf16x8*)(lds + PG8_SA(b, h) + aoff + m * 2048 + 1024); \
        if constexpr (F8) { dst##8[m] = cat8(x0_, x1_); } else { dst[m][0] = x0_; dst[m][1] = x1_; } } } while (0)
#define PG8_LDB(dst, b, h) do { _Pragma("unroll") for (int n = 0; n < 2; ++n) { const bf16x8 x0_ = *(const PG8_LAS bf16x8*)(lds + PG8_SB(b, h) + boff + n * 2048), x1_ = *(const PG8_LAS bf16x8*)(lds + PG8_SB(b, h) + boff + n * 2048 + 1024); \
        if constexpr (F8) { dst##8[n] = cat8(x0_, x1_); } else { dst[n][0] = x0_; dst[n][1] = x1_; } } } while (0)
#define PG8_MMA(ai, bj, At, Bt) do { __builtin_amdgcn_s_setprio(1); _Pragma("unroll") for (int m = 0; m < 4; ++m) _Pragma("unroll") for (int n = 0; n < 2; ++n) { \
        if constexpr (F8) { asm volatile("v_mfma_scale_f32_16x16x128_f8f6f4 %0, %1, %2, %0, %3, %3 op_sel_hi:[0,0,0]" : "+v"(acc[ai][bj][m][n]) : "v"(Bt##8[n]), "v"(At##8[m]), "v"(f8scale)); } \
        else { _Pragma("unroll") for (int k = 0; k < 2; ++k) acc[ai][bj][m][n] = __builtin_amdgcn_mfma_f32_16x16x32_bf16(Bt[n][k], At[m][k], acc[ai][bj][m][n], 0, 0, 0); } } \
        __builtin_amdgcn_s_setprio(0); } while (0)
#define PG8_WAIT_V(n) asm volatile("s_waitcnt vmcnt(" #n ")" ::: "memory")
#define PG8_WAIT_L(n) asm volatile("s_waitcnt lgkmcnt(" #n ")" ::: "memory")
#define PG8_BAR __builtin_amdgcn_s_barrier()
#define PG8_SCHED __builtin_amdgcn_sched_barrier(0)
    Unit cur, nxt; int ui = 0;
    if (!S.next(0, cur)) return;
    f32x4 acc[2][2][4][2];
#pragma unroll
    for (int a = 0; a < 2; ++a)
#pragma unroll
        for (int b = 0; b < 2; ++b)
#pragma unroll
            for (int m = 0; m < 4; ++m)
#pragma unroll
                for (int n = 0; n < 2; ++n) acc[a][b][m][n] = (f32x4){0.f, 0.f, 0.f, 0.f};
    const int f8scale = 0x7f7f7f7f;
    bf16x8 At[4][2], B0[2][2], B1[2][2]; v8i32 At8[4], B08[2], B18[2];
    const char* cA = (const char*)g.A + (size_t)cur.pm * tstep; const char* cB = (const char*)g.Bt + (size_t)cur.pn * tstep;
    S.a_ready(cur);
    if constexpr (SP2) {
        PG8_STAGE(PG8_SB(0, 0), cB, voffB); PG8_STAGE(PG8_SB(0, 1), cB + hstep, voffB); PG8_STAGE(PG8_SA(0, 0), cA, voffA); PG8_STAGE(PG8_SA(0, 1), cA + hstep, voffA);
        if (wr == 1) PG8_BAR;
        PG8_WAIT_V(2); PG8_BAR;
        PG8_STAGE(PG8_SB(1, 0), cB + kstep, voffB); PG8_STAGE(PG8_SA(1, 0), cA + kstep, voffA); PG8_STAGE(PG8_SB(1, 1), cB + hstep + kstep, voffB);
        PG8_WAIT_V(6); PG8_BAR;
    } else {
        PG8_STAGE(PG8_SB(0, 0), cB, voffB); PG8_STAGE(PG8_SA(0, 0), cA, voffA); PG8_STAGE(PG8_SB(0, 1), cB + hstep, voffB); PG8_STAGE(PG8_SA(0, 1), cA + hstep, voffA);
        if (wr == 1) PG8_BAR;
        PG8_WAIT_V(4); PG8_BAR;
        PG8_STAGE(PG8_SB(1, 0), cB + kstep, voffB); PG8_STAGE(PG8_SA(1, 0), cA + kstep, voffA); PG8_STAGE(PG8_SB(1, 1), cB + hstep + kstep, voffB);
        PG8_WAIT_V(6); PG8_BAR;
    }
    for (;;) {
        const bool has_next = S.next(ui + 1, nxt);
        const char* nA = has_next ? (const char*)g.A + (size_t)nxt.pm * tstep : cA; const char* nB = has_next ? (const char*)g.Bt + (size_t)nxt.pn * tstep : cB;
        for (int t = 0; t < nt; t += 2) {
            const bool last = (t == nt - 2);
            const char* a1 = cA + (size_t)(t + 1) * kstep;
            const char* a2 = last ? nA : cA + (size_t)(t + 2) * kstep; const char* b2 = last ? nB : cB + (size_t)(t + 2) * kstep;
            const char* a3 = a2 + kstep; const char* b3 = b2 + kstep;
            if (last && has_next) S.a_ready(nxt);
            if constexpr (SP2) {
            PG8_LDB(B0, 0, 0); PG8_LDB(B1, 0, 1); PG8_SCHED; PG8_LDA(At, 0, 0); PG8_STAGE(PG8_SA(1, 1), a1 + hstep, voffA);
            PG8_WAIT_V(8); PG8_WAIT_L(0); PG8_BAR; PG8_MMA(0, 0, At, B0); PG8_MMA(0, 1, At, B1); PG8_BAR; PG8_SCHED;
            PG8_LDA(At, 0, 1); PG8_STAGE(PG8_SB(0, 0), b2, voffB); PG8_STAGE(PG8_SB(0, 1), b2 + hstep, voffB); PG8_STAGE(PG8_SA(0, 0), a2, voffA);
            PG8_WAIT_V(8); PG8_WAIT_L(0); PG8_BAR; PG8_MMA(1, 0, At, B0); PG8_MMA(1, 1, At, B1); PG8_BAR; PG8_SCHED;
            PG8_LDB(B0, 1, 0); PG8_LDB(B1, 1, 1); PG8_SCHED; PG8_LDA(At, 1, 0); PG8_STAGE(PG8_SA(0, 1), a2 + hstep, voffA);
            PG8_WAIT_V(8); PG8_WAIT_L(0); PG8_BAR; PG8_MMA(0, 0, At, B0); PG8_MMA(0, 1, At, B1); PG8_BAR; PG8_SCHED;
            PG8_LDA(At, 1, 1); PG8_STAGE(PG8_SB(1, 0), b3, voffB); PG8_STAGE(PG8_SB(1, 1), b3 + hstep, voffB); PG8_STAGE(PG8_SA(1, 0), a3, voffA);
            PG8_WAIT_V(8); PG8_WAIT_L(0); PG8_BAR; PG8_MMA(1, 0, At, B0); PG8_MMA(1, 1, At, B1); PG8_BAR; PG8_SCHED;
            } else {
            PG8_LDB(B0, 0, 0); PG8_SCHED; PG8_LDA(At, 0, 0); PG8_STAGE(PG8_SA(1, 1), a1 + hstep, voffA);
            PG8_WAIT_L(8); PG8_BAR; PG8_WAIT_L(0); PG8_MMA(0, 0, At, B0); PG8_BAR; PG8_SCHED;
            PG8_LDB(B1, 0, 1); PG8_STAGE(PG8_SB(0, 0), b2, voffB);
            PG8_BAR; PG8_WAIT_L(0); PG8_MMA(0, 1, At, B1); PG8_BAR;
            PG8_LDA(At, 0, 1); PG8_STAGE(PG8_SA(0, 0), a2, voffA);
            PG8_BAR; PG8_WAIT_L(0); PG8_MMA(1, 0, At, B0); PG8_BAR; PG8_SCHED;
            PG8_STAGE(PG8_SB(0, 1), b2 + hstep, voffB);
            PG8_WAIT_V(6); PG8_BAR; PG8_MMA(1, 1, At, B1); PG8_BAR;
            PG8_LDB(B0, 1, 0); PG8_SCHED; PG8_LDA(At, 1, 0); PG8_STAGE(PG8_SA(0, 1), a2 + hstep, voffA);
            PG8_WAIT_L(8); PG8_BAR; PG8_WAIT_L(0); PG8_MMA(0, 0, At, B0); PG8_BAR; PG8_SCHED;
            PG8_LDB(B1, 1, 1); PG8_STAGE(PG8_SB(1, 0), b3, voffB);
            PG8_BAR; PG8_WAIT_L(0); PG8_MMA(0, 1, At, B1); PG8_BAR;
            PG8_LDA(At, 1, 1); PG8_STAGE(PG8_SA(1, 0), a3, voffA);
            PG8_BAR; PG8_WAIT_L(0); PG8_MMA(1, 0, At, B0); PG8_BAR; PG8_SCHED;
            PG8_STAGE(PG8_SB(1, 1), b3 + hstep, voffB);
            PG8_WAIT_V(6); PG8_BAR; PG8_MMA(1, 1, At, B1); PG8_BAR;
            }
        }
        if constexpr (ALIGN_EPI) { if (wr == 0) PG8_BAR; }
        if constexpr (F8) { asm volatile("s_nop 15\n\ts_nop 15" ::: "memory"); }
        if constexpr (!Epi::AFTER_DRAIN) { E(acc, cur, wr, wc, fr, fq); S.done(cur); }
        if (!has_next) break;
#pragma unroll
        for (int a = 0; a < 2; ++a)
#pragma unroll
            for (int b = 0; b < 2; ++b)
#pragma unroll
                for (int m = 0; m < 4; ++m)
#pragma unroll
                    for (int n = 0; n < 2; ++n) acc[a][b][m][n] = (f32x4){0.f, 0.f, 0.f, 0.f};
        cur = nxt; cA = nA; cB = nB; ++ui;
        if constexpr (ALIGN_EPI) { if (wr == 1) PG8_BAR; }
    }
    PG8_WAIT_V(0);
    if constexpr (!ALIGN_EPI) { if (wr == 0) PG8_BAR; }
    PG8_BAR;
    if constexpr (Epi::AFTER_DRAIN) { E.fused(acc, cur, wr, wc, fr, fq, lds, wid, lane); S.done(cur); }
#undef PG8_SA
#undef PG8_SB
#undef PG8_STAGE
#undef PG8_LDA
#undef PG8_LDB
#undef PG8_MMA
#undef PG8_WAIT_V
#undef PG8_WAIT_L
#undef PG8_BAR
#undef PG8_SCHED
}
}

constexpr int NB = 8, SEQ = 2048, DM = 1024, DEPTH = 4, T = NB * SEQ;
constexpr int DIN = 2756, NP = 2816;
constexpr int DFF = 2816, NE = 8, MODW = 6 * DM;
constexpr int C_QA = 0, C_KA = 384, C_VA = 448, C_QI = 512, C_KI = 768, C_QB = 832, C_KB = 1088, C_VB = 1344, C_QC = 1600, C_KC = 1984, C_VC = 2368, C_WI = 2752;
constexpr float LOG2E = 1.4426950408889634f;
constexpr float SCALE_A = 0.125f * LOG2E;
constexpr float SCALE_B = 0.17677669529663687f * LOG2E;

namespace pg8 {
__device__ __forceinline__ float row_rstd(const float* SSP, int row) {
    const f32x4* p = (const f32x4*)(SSP + (size_t)row * 16);
    const f32x4 a = p[0], b = p[1], c = p[2], d = p[3];
    const float s = ((a.x + a.y) + (a.z + a.w)) + ((b.x + b.y) + (b.z + b.w)) + ((c.x + c.y) + (c.z + c.w)) + ((d.x + d.y) + (d.z + d.w));
    return 1.f / sqrtf(s * (1.f / DM) + 1e-6f);
}
struct EpiProj {
    static constexpr bool PERM = true, AFTER_DRAIN = false;
    bf16_t* P; float* WI; const float* rope;
    const float* SSP; const float* bias;
    __device__ __forceinline__ void operator()(const f32x4 (&acc)[2][2][4][2], const Unit& u, int wr, int wc, int fr, int fq) const {
        const int row0 = u.pm * BM + wr * 64 + fr;
#pragma unroll
        for (int bj = 0; bj < 2; ++bj) {
            const int cw = u.pn * BM + bj * HALF + wc * 32;
            const int g = cw >> 6;
            const int c0 = cw + 8 * fq;
            int type = 0; float scale = 1.f;
            if (g < 6) { type = 1; scale = SCALE_A; }
            else if (g == 6) { type = 1; }
            else if (g == 7) { type = 0; }
            else if (g < 13) { type = 1; }
            else if (g < 17) { type = 2; scale = SCALE_B; }
            else if (g < 21) { type = 2; }
            else if (g < 25) { type = 0; }
            else if (g < 31) { type = 1; scale = SCALE_A; }
            else if (g < 37) { type = 1; }
            else { type = 0; }
            const bool rope64 = (type == 1) && ((wc & 1) == 0);
            f32x4 ra0, ra1, ra2, ra3, rb0, rb1, rb2, rb3;
            const int rofs = rope64 ? 0 : 16;
            const bool rot = rope64 || type == 2;
            ra0 = ra1 = ra2 = ra3 = rb0 = rb1 = rb2 = rb3 = (f32x4){0.f, 0.f, 0.f, 0.f};
#define EP_ROPE_LOAD(idx, R0, R1, R2, R3) do { const float* rp_ = rope + (size_t)(row0 + ((idx) >> 2) * HALF + ((idx) & 3) * 16) * 24 + rofs; \
                R0 = *(const f32x4*)(rp_); R1 = *(const f32x4*)(rp_ + 4); if (rope64) { R2 = *(const f32x4*)(rp_ + 8); R3 = *(const f32x4*)(rp_ + 12); } } while (0)
#define EP_GROUP(idx, R0, R1, R2, R3) do { \
                const int ai = (idx) >> 2, m = (idx) & 3; \
                const int row = row0 + ai * HALF + m * 16; \
                f32x4 v0 = acc[ai][bj][m][0], v1 = acc[ai][bj][m][1]; \
                const f32x4 r0 = R0, r1 = R1, r2 = R2, r3 = R3; \
                if (rot && (idx) + 2 < 8) EP_ROPE_LOAD((idx) + 2, R0, R1, R2, R3); \
                if (rope64) { \
                    f32x4 p0, p1; \
                    p0.x = __shfl_xor(v0.x, 16); p0.y = __shfl_xor(v0.y, 16); p0.z = __shfl_xor(v0.z, 16); p0.w = __shfl_xor(v0.w, 16); \
                    p1.x = __shfl_xor(v1.x, 16); p1.y = __shfl_xor(v1.y, 16); p1.z = __shfl_xor(v1.z, 16); p1.w = __shfl_xor(v1.w, 16); \
                    if (fq == 0) { v0 = v0 * r0 - p0 * r2; v1 = v1 * r1 - p1 * r3; }             \
                    else if (fq == 1) { v0 = v0 * r0 + p0 * r2; v1 = v1 * r1 + p1 * r3; }        \
                } else if (type == 2) { \
                    if (fq == 0) { const f32x4 x1 = v0, x2 = v1; v0 = x1 * r0 - x2 * r1; v1 = x2 * r0 + x1 * r1; }     \
                } \
                if (g == 43 && wc == 2 && fq == 0) *(f32x4*)(WI + (size_t)row * 4) = v0;       \
                v0 = v0 * scale; v1 = v1 * scale; \
                u32x4 w; w.x = cvt_pk_bf16(v0[0], v0[1]); w.y = cvt_pk_bf16(v0[2], v0[3]); w.z = cvt_pk_bf16(v1[0], v1[1]); w.w = cvt_pk_bf16(v1[2], v1[3]); \
                *(u32x4*)(P + (size_t)row * NP + c0) = w; } while (0)
            if (rot) { EP_ROPE_LOAD(0, ra0, ra1, ra2, ra3); EP_ROPE_LOAD(1, rb0, rb1, rb2, rb3); }
            EP_GROUP(0, ra0, ra1, ra2, ra3); EP_GROUP(1, rb0, rb1, rb2, rb3); EP_GROUP(2, ra0, ra1, ra2, ra3); EP_GROUP(3, rb0, rb1, rb2, rb3);
            EP_GROUP(4, ra0, ra1, ra2, ra3); EP_GROUP(5, rb0, rb1, rb2, rb3); EP_GROUP(6, ra0, ra1, ra2, ra3); EP_GROUP(7, rb0, rb1, rb2, rb3);
#undef EP_GROUP
#undef EP_ROPE_LOAD
        }
    }
};
template <int NOUT, bool XF32 = false>
struct EpiResid {
    static constexpr bool PERM = true, AFTER_DRAIN = false;
    const void* xin; bf16_t* xout; const float* gate;
    void* XS; const float* gn; const float* scn; float* SSP; float f8h;
    __device__ __forceinline__ void operator()(const f32x4 (&acc)[2][2][4][2], const Unit& u, int wr, int wc, int fr, int fq) const {
        const int row0 = u.pm * BM + wr * 64 + fr, col0 = u.pn * BM + wc * 32 + 8 * fq;
        const int b = u.pm >> 3;
        f32x4 gv[2][2];
#pragma unroll
        for (int bj = 0; bj < 2; ++bj)
#pragma unroll
            for (int n = 0; n < 2; ++n) gv[bj][n] = *(const f32x4*)(gate + (size_t)b * MODW + col0 + bj * HALF + 4 * n) * (NOUT == 0 ? f8h : 1.f);
#pragma unroll
        for (int ai = 0; ai < 2; ++ai)
#pragma unroll
            for (int m = 0; m < 4; ++m) {
                const int row = row0 + ai * HALF + m * 16;
                bf16_t* xo = xout + (size_t)row * DM + col0;
#pragma unroll
                for (int bj = 0; bj < 2; ++bj) {
                    f32x4 x0, x1;
                    if (XF32) { const float* xi = (const float*)xin + (size_t)row * DM + col0 + bj * HALF; x0 = *(const f32x4*)xi; x1 = *(const f32x4*)(xi + 4); }
                    else { const u32x4 w_ = *(const u32x4*)((const bf16_t*)xin + (size_t)row * DM + col0 + bj * HALF);
                           x0 = (f32x4){__builtin_bit_cast(float, w_.x << 16), __builtin_bit_cast(float, w_.x & 0xffff0000u), __builtin_bit_cast(float, w_.y << 16), __builtin_bit_cast(float, w_.y & 0xffff0000u)};
                           x1 = (f32x4){__builtin_bit_cast(float, w_.z << 16), __builtin_bit_cast(float, w_.z & 0xffff0000u), __builtin_bit_cast(float, w_.w << 16), __builtin_bit_cast(float, w_.w & 0xffff0000u)}; }
                    const f32x4 n0 = x0 + gv[bj][0] * acc[ai][bj][m][0], n1 = x1 + gv[bj][1] * acc[ai][bj][m][1];
                    u32x4 w; w.x = cvt_pk_bf16(n0[0], n0[1]); w.y = cvt_pk_bf16(n0[2], n0[3]); w.z = cvt_pk_bf16(n1[0], n1[1]); w.w = cvt_pk_bf16(n1[2], n1[3]);
                    *(u32x4*)(xo + bj * HALF) = w;
                }
            }
    }
};
template <bool XF32, bool OUT8>
struct EpiResidNorm {
    static constexpr bool PERM = true, AFTER_DRAIN = true;
    const void* xin; bf16_t* xout; const float* gate;
    const float* gn; const float* modn; int off_sh, off_sc;
    void* H; float* slots; unsigned* cnt; float f8h;
    float accs;
    __device__ __forceinline__ void fused(f32x4 (&acc)[2][2][4][2], const Unit& u, int wr, int wc, int fr, int fq, PG8_LAS unsigned char* lds, int wid, int lane) const {
        PG8_LAS float* P = (PG8_LAS float*)lds;
        PG8_LAS float* S = (PG8_LAS float*)(lds + 8192);
        const int row0 = u.pm * BM + wr * 64 + fr, col0 = u.pn * BM + wc * 32 + 8 * fq;
        const int b = u.pm >> 3;
        {
            f32x4 gv[2][2];
#pragma unroll
            for (int bj = 0; bj < 2; ++bj)
#pragma unroll
                for (int n = 0; n < 2; ++n) gv[bj][n] = *(const f32x4*)(gate + (size_t)b * MODW + col0 + bj * HALF + 4 * n) * accs;
#pragma unroll
            for (int ai = 0; ai < 2; ++ai)
#pragma unroll
                for (int m = 0; m < 4; ++m) {
                    const int row = row0 + ai * HALF + m * 16;
                    float s = 0.f;
#pragma unroll
                    for (int bj = 0; bj < 2; ++bj) {
                        f32x4 x0, x1;
                        if (XF32) { const float* xi = (const float*)xin + (size_t)row * DM + col0 + bj * HALF; x0 = *(const f32x4*)xi; x1 = *(const f32x4*)(xi + 4); }
                        else { const u32x4 w_ = *(const u32x4*)((const bf16_t*)xin + (size_t)row * DM + col0 + bj * HALF);
                               x0 = (f32x4){__builtin_bit_cast(float, w_.x << 16), __builtin_bit_cast(float, w_.x & 0xffff0000u), __builtin_bit_cast(float, w_.y << 16), __builtin_bit_cast(float, w_.y & 0xffff0000u)};
                               x1 = (f32x4){__builtin_bit_cast(float, w_.z << 16), __builtin_bit_cast(float, w_.z & 0xffff0000u), __builtin_bit_cast(float, w_.w << 16), __builtin_bit_cast(float, w_.w & 0xffff0000u)}; }
                        const f32x4 n0 = x0 + gv[bj][0] * acc[ai][bj][m][0], n1 = x1 + gv[bj][1] * acc[ai][bj][m][1];
                        acc[ai][bj][m][0] = n0; acc[ai][bj][m][1] = n1;
                        s += ((n0[0] * n0[0] + n0[1] * n0[1]) + (n0[2] * n0[2] + n0[3] * n0[3])) + ((n1[0] * n1[0] + n1[1] * n1[1]) + (n1[2] * n1[2] + n1[3] * n1[3]));
                    }
                    s += __shfl_xor(s, 16); s += __shfl_xor(s, 32);
                    if (fq == 0) P[(ai * HALF + wr * 64 + m * 16 + fr) * 4 + wc] = s;
                }
        }
        asm volatile("s_waitcnt lgkmcnt(0)" ::: "memory"); __builtin_amdgcn_s_barrier(); asm volatile("" ::: "memory");
        const int rl = wid * 32 + (lane & 31);
        if (lane < 32) {
            const f32x4 p = *(const PG8_LAS f32x4*)(P + rl * 4);
            __hip_atomic_store((unsigned*)slots + (size_t)(u.pm * BM + rl) * 4 + u.pn, __builtin_bit_cast(unsigned, (p[0] + p[1]) + (p[2] + p[3])), __ATOMIC_RELAXED, __HIP_MEMORY_SCOPE_AGENT);
        }
        asm volatile("s_waitcnt vmcnt(0)" ::: "memory");
        if (lane == 0) __hip_atomic_fetch_add(cnt + 8 * u.pm, 1u, __ATOMIC_RELAXED, __HIP_MEMORY_SCOPE_AGENT);
        f32x4 gsv[2][2], shv[2][2];
#pragma unroll
        for (int bj = 0; bj < 2; ++bj)
#pragma unroll
            for (int n = 0; n < 2; ++n) { const int col = col0 + bj * HALF + 4 * n;
                gsv[bj][n] = *(const f32x4*)(gn + col) * (*(const f32x4*)(modn + (size_t)b * MODW + off_sc + col) + 1.f); shv[bj][n] = *(const f32x4*)(modn + (size_t)b * MODW + off_sh + col); }
        if (wid == 0) {
            for (;;) {
                if ((unsigned)__builtin_amdgcn_readfirstlane(__hip_atomic_load(cnt + 8 * u.pm, __ATOMIC_RELAXED, __HIP_MEMORY_SCOPE_AGENT)) >= 32u) break;
                __builtin_amdgcn_s_sleep(2);
            }
            __builtin_amdgcn_fence(__ATOMIC_ACQUIRE, "agent");
        }
        asm volatile("s_waitcnt vmcnt(0) lgkmcnt(0)" ::: "memory"); __builtin_amdgcn_s_barrier(); asm volatile("" ::: "memory");
        if (lane < 32) {
            const unsigned* sl = (const unsigned*)slots + (size_t)(u.pm * BM + rl) * 4; float t = 0.f;
#pragma unroll
            for (int k = 0; k < 4; ++k) t += __builtin_bit_cast(float, __hip_atomic_load(sl + k, __ATOMIC_RELAXED, __HIP_MEMORY_SCOPE_AGENT));
            S[rl] = 1.f / sqrtf(t * (1.f / DM) + 1e-6f);
        }
        asm volatile("s_waitcnt vmcnt(0) lgkmcnt(0)" ::: "memory"); __builtin_amdgcn_s_barrier(); asm volatile("" ::: "memory");
#pragma unroll
        for (int ai = 0; ai < 2; ++ai)
#pragma unroll
            for (int m = 0; m < 4; ++m) {
                const int rt = ai * HALF + wr * 64 + m * 16 + fr; const float r = S[rt];
                const size_t row = (size_t)(u.pm * BM + rt);
#pragma unroll
                for (int bj = 0; bj < 2; ++bj) {
                    const f32x4 n0 = acc[ai][bj][m][0], n1 = acc[ai][bj][m][1];
                    { u32x4 w; w.x = cvt_pk_bf16(n0[0], n0[1]); w.y = cvt_pk_bf16(n0[2], n0[3]); w.z = cvt_pk_bf16(n1[0], n1[1]); w.w = cvt_pk_bf16(n1[2], n1[3]);
                      *(u32x4*)(xout + row * DM + col0 + bj * HALF) = w; }
                    const f32x4 h0 = (n0 * r) * gsv[bj][0] + shv[bj][0], h1 = (n1 * r) * gsv[bj][1] + shv[bj][1];
                    if (OUT8) { unsigned w0 = 0u, w1 = 0u;
                        w0 = __builtin_amdgcn_cvt_pk_fp8_f32(h0[0] * f8h, h0[1] * f8h, w0, false); w0 = __builtin_amdgcn_cvt_pk_fp8_f32(h0[2] * f8h, h0[3] * f8h, w0, true);
                        w1 = __builtin_amdgcn_cvt_pk_fp8_f32(h1[0] * f8h, h1[1] * f8h, w1, false); w1 = __builtin_amdgcn_cvt_pk_fp8_f32(h1[2] * f8h, h1[3] * f8h, w1, true);
                        *(unsigned long long*)((unsigned char*)H + row * DM + col0 + bj * HALF) = (unsigned long long)w0 | ((unsigned long long)w1 << 32);
                    } else { u32x4 w; w.x = cvt_pk_bf16(h0[0], h0[1]); w.y = cvt_pk_bf16(h0[2], h0[3]); w.z = cvt_pk_bf16(h1[0], h1[1]); w.w = cvt_pk_bf16(h1[2], h1[3]);
                        *(u32x4*)((bf16_t*)H + row * DM + col0 + bj * HALF) = w; }
                }
            }
    }
};
struct EpiResidNormRoute {
    static constexpr bool PERM = true, AFTER_DRAIN = true;
    const void* xin; bf16_t* xout; const float* gate;
    const float* gn; const float* modn; int off_sh, off_sc;
    void* H; float* slots; unsigned* cnt; float f8h;
    const float* wrt; int* LIST; int* ENTI; float* ENTW; unsigned* gcnt;
    const float* bias8;
    __device__ __forceinline__ void fused(f32x4 (&acc)[2][2][4][2], const Unit& u, int wr, int wc, int fr, int fq, PG8_LAS unsigned char* lds, int wid, int lane) const {
        PG8_LAS float* P = (PG8_LAS float*)lds;
        PG8_LAS float* S = (PG8_LAS float*)(lds + 49152);
        PG8_LAS float* GW = S + 256;
        PG8_LAS int* le = (PG8_LAS int*)(GW + 2048);
        PG8_LAS int* lp = le + 512;
        PG8_LAS float* lw = (PG8_LAS float*)(lp + 512);
        PG8_LAS unsigned* lcnt = (PG8_LAS unsigned*)(lw + 512);
        PG8_LAS unsigned* lbase = lcnt + 8;
        const int tid = wid * 64 + lane;
        const int row0 = u.pm * BM + wr * 64 + fr, col0 = u.pn * BM + wc * 32 + 8 * fq;
        const int b = u.pm >> 3;
        if (tid < 8) lcnt[tid] = 0u;
        const int c4_ = u.pn * BM + 4 * (tid & 63);
        const f32x4 st_g = *(const f32x4*)(gn + c4_), st_sc = *(const f32x4*)(modn + (size_t)b * MODW + off_sc + c4_), st_w = *(const f32x4*)(wrt + (tid >> 6) * DM + c4_);
        {
            f32x4 gv[2][2];
#pragma unroll
            for (int bj = 0; bj < 2; ++bj)
#pragma unroll
                for (int n = 0; n < 2; ++n) gv[bj][n] = *(const f32x4*)(gate + (size_t)b * MODW + col0 + bj * HALF + 4 * n);
#pragma unroll
            for (int ai = 0; ai < 2; ++ai)
#pragma unroll
                for (int m = 0; m < 4; ++m) {
                    const int row = row0 + ai * HALF + m * 16;
                    float s = 0.f;
#pragma unroll
                    for (int bj = 0; bj < 2; ++bj) {
                        const u32x4 w_ = *(const u32x4*)((const bf16_t*)xin + (size_t)row * DM + col0 + bj * HALF);
                        const f32x4 x0 = (f32x4){__builtin_bit_cast(float, w_.x << 16), __builtin_bit_cast(float, w_.x & 0xffff0000u), __builtin_bit_cast(float, w_.y << 16), __builtin_bit_cast(float, w_.y & 0xffff0000u)};
                        const f32x4 x1 = (f32x4){__builtin_bit_cast(float, w_.z << 16), __builtin_bit_cast(float, w_.z & 0xffff0000u), __builtin_bit_cast(float, w_.w << 16), __builtin_bit_cast(float, w_.w & 0xffff0000u)};
                        const f32x4 n0 = x0 + gv[bj][0] * acc[ai][bj][m][0], n1 = x1 + gv[bj][1] * acc[ai][bj][m][1];
                        acc[ai][bj][m][0] = n0; acc[ai][bj][m][1] = n1;
                        s += ((n0[0] * n0[0] + n0[1] * n0[1]) + (n0[2] * n0[2] + n0[3] * n0[3])) + ((n1[0] * n1[0] + n1[1] * n1[1]) + (n1[2] * n1[2] + n1[3] * n1[3]));
                    }
                    s += __shfl_xor(s, 16); s += __shfl_xor(s, 32);
                    if (fq == 0) P[((ai * HALF + wr * 64 + m * 16 + fr) * 4 + wc) * 12] = s;
                }
        }
        f32x4 gsv[2][2];
#pragma unroll
        for (int bj = 0; bj < 2; ++bj)
#pragma unroll
            for (int n = 0; n < 2; ++n) { const int col = col0 + bj * HALF + 4 * n; gsv[bj][n] = *(const f32x4*)(gn + col) * (*(const f32x4*)(modn + (size_t)b * MODW + off_sc + col) + 1.f); }
        *(PG8_LAS f32x4*)(GW + (tid >> 6) * 256 + 4 * (tid & 63)) = (st_g * (st_sc + 1.f)) * st_w;
        asm volatile("s_waitcnt vmcnt(0) lgkmcnt(0)" ::: "memory"); __builtin_amdgcn_s_barrier(); asm volatile("" ::: "memory");
#pragma unroll 1
        for (int e = 0; e < 8; ++e) {
            f32x4 gw[2][2];
#pragma unroll
            for (int bj = 0; bj < 2; ++bj)
#pragma unroll
                for (int n = 0; n < 2; ++n) gw[bj][n] = *(const PG8_LAS f32x4*)(GW + e * 256 + wc * 32 + 8 * fq + bj * HALF + 4 * n);
            float dv[8];
#pragma unroll
            for (int ai = 0; ai < 2; ++ai)
#pragma unroll
                for (int m = 0; m < 4; ++m) {
                    const f32x4 d4 = (acc[ai][0][m][0] * gw[0][0] + acc[ai][0][m][1] * gw[0][1]) + (acc[ai][1][m][0] * gw[1][0] + acc[ai][1][m][1] * gw[1][1]);
                    dv[ai * 4 + m] = (d4[0] + d4[1]) + (d4[2] + d4[3]);
                }
#pragma unroll
            for (int k = 0; k < 8; ++k) dv[k] += __shfl_xor(dv[k], 16);
#pragma unroll
            for (int k = 0; k < 8; ++k) dv[k] += __shfl_xor(dv[k], 32);
            if (fq == 0) {
#pragma unroll
                for (int ai = 0; ai < 2; ++ai)
#pragma unroll
                    for (int m = 0; m < 4; ++m) P[((ai * HALF + wr * 64 + m * 16 + fr) * 4 + wc) * 12 + 1 + e] = dv[ai * 4 + m];
            }
        }
        asm volatile("s_waitcnt lgkmcnt(0)" ::: "memory"); __builtin_amdgcn_s_barrier(); asm volatile("" ::: "memory");
        const int rl = wid * 32 + (lane & 31);
        unsigned long long* sl = (unsigned long long*)slots + ((size_t)(u.pm * BM + rl) * 4) * 6;
        if (lane < 32) {
            f32x4 t0 = {0.f, 0.f, 0.f, 0.f}, t1 = t0, t2 = t0;
#pragma unroll
            for (int w = 0; w < 4; ++w) { const PG8_LAS f32x4* p = (const PG8_LAS f32x4*)(P + (rl * 4 + w) * 12); t0 += p[0]; t1 += p[1]; t2 += p[2]; }
            unsigned long long* so = sl + u.pn * 6;
            const float f0 = t0[0], f1 = t0[1], f2 = t0[2], f3 = t0[3], f4 = t1[0], f5 = t1[1], f6 = t1[2], f7 = t1[3], f8 = t2[0];
#define PK64_(a, b) ((unsigned long long)__builtin_bit_cast(unsigned, a) | ((unsigned long long)__builtin_bit_cast(unsigned, b) << 32))
            __hip_atomic_store(so + 0, PK64_(f0, f1), __ATOMIC_RELAXED, __HIP_MEMORY_SCOPE_AGENT);
            __hip_atomic_store(so + 1, PK64_(f2, f3), __ATOMIC_RELAXED, __HIP_MEMORY_SCOPE_AGENT);
            __hip_atomic_store(so + 2, PK64_(f4, f5), __ATOMIC_RELAXED, __HIP_MEMORY_SCOPE_AGENT);
            __hip_atomic_store(so + 3, PK64_(f6, f7), __ATOMIC_RELAXED, __HIP_MEMORY_SCOPE_AGENT);
            __hip_atomic_store(so + 4, (unsigned long long)__builtin_bit_cast(unsigned, f8), __ATOMIC_RELAXED, __HIP_MEMORY_SCOPE_AGENT);
#undef PK64_
        }
        asm volatile("s_waitcnt vmcnt(0)" ::: "memory");
        if (lane == 0) __hip_atomic_fetch_add(cnt + 8 * u.pm, 1u, __ATOMIC_RELAXED, __HIP_MEMORY_SCOPE_AGENT);
        int vz_; asm volatile("v_mov_b32 %0, 0" : "=v"(vz_));
        const f32x4 bsa = *(const f32x4*)(bias8 + b * 8 + vz_), bsb = *(const f32x4*)(bias8 + b * 8 + 4 + vz_);
        if (wid == 0) {
            for (;;) {
                if ((unsigned)__builtin_amdgcn_readfirstlane(__hip_atomic_load(cnt + 8 * u.pm, __ATOMIC_RELAXED, __HIP_MEMORY_SCOPE_AGENT)) >= 32u) break;
                __builtin_amdgcn_s_sleep(2);
            }
            __builtin_amdgcn_fence(__ATOMIC_ACQUIRE, "agent");
        }
        asm volatile("s_waitcnt vmcnt(0) lgkmcnt(0)" ::: "memory"); __builtin_amdgcn_s_barrier(); asm volatile("" ::: "memory");
        if (lane < 32) {
            float t[10];
#pragma unroll
            for (int k = 0; k < 10; ++k) t[k] = 0.f;
#pragma unroll
            for (int o = 0; o < 4; ++o)
#pragma unroll
                for (int k2 = 0; k2 < 5; ++k2) { const unsigned long long w = __hip_atomic_load(sl + o * 6 + k2, __ATOMIC_RELAXED, __HIP_MEMORY_SCOPE_AGENT);
                    t[2 * k2] += __builtin_bit_cast(float, (unsigned)w); t[2 * k2 + 1] += __builtin_bit_cast(float, (unsigned)(w >> 32)); }
            const float rstd = 1.f / sqrtf(t[0] * (1.f / DM) + 1e-6f);
            S[rl] = rstd;
            if (u.pn == 0) {
                float pe[8];
#pragma unroll
                for (int e = 0; e < 8; ++e) pe[e] = rstd * t[1 + e] + (e < 4 ? bsa[e & 3] : bsb[e & 3]);
                int i0 = 0; float v0 = pe[0];
#pragma unroll
                for (int e = 1; e < 8; ++e) if (pe[e] > v0) { v0 = pe[e]; i0 = e; }
                int i1 = -1; float v1 = -INFINITY;
#pragma unroll
                for (int e = 0; e < 8; ++e) if (e != i0 && pe[e] > v1) { v1 = pe[e]; i1 = e; }
                const float e1 = __expf(v1 - v0), w0 = 1.f / (1.f + e1), w1 = e1 / (1.f + e1);
                le[2 * rl] = i0; le[2 * rl + 1] = i1; lw[2 * rl] = w0; lw[2 * rl + 1] = w1;
                lp[2 * rl] = (int)__hip_atomic_fetch_add(lcnt + i0, 1u, __ATOMIC_RELAXED, __HIP_MEMORY_SCOPE_WORKGROUP);
                lp[2 * rl + 1] = (int)__hip_atomic_fetch_add(lcnt + i1, 1u, __ATOMIC_RELAXED, __HIP_MEMORY_SCOPE_WORKGROUP);
            }
        }
        asm volatile("s_waitcnt vmcnt(0) lgkmcnt(0)" ::: "memory"); __builtin_amdgcn_s_barrier(); asm volatile("" ::: "memory");
        if (u.pn == 0) {
            if (tid < 8) lbase[tid] = __hip_atomic_fetch_add(gcnt + tid, lcnt[tid], __ATOMIC_RELAXED, __HIP_MEMORY_SCOPE_AGENT);
            asm volatile("s_waitcnt vmcnt(0) lgkmcnt(0)" ::: "memory"); __builtin_amdgcn_s_barrier(); asm volatile("" ::: "memory");
            { const int m = u.pm * BM + (tid >> 1), k = tid & 1, e = le[tid], p = (int)lbase[e] + lp[tid];
              LIST[(size_t)e * T + p] = m; ENTI[(size_t)m * 4 + 2 * k] = e; ENTI[(size_t)m * 4 + 2 * k + 1] = p; ENTW[(size_t)m * 2 + k] = lw[tid]; }
        }
        f32x4 shv[2][2];
#pragma unroll
        for (int bj = 0; bj < 2; ++bj)
#pragma unroll
            for (int n = 0; n < 2; ++n) shv[bj][n] = *(const f32x4*)(modn + (size_t)b * MODW + off_sh + col0 + bj * HALF + 4 * n);
#pragma unroll
        for (int ai = 0; ai < 2; ++ai)
#pragma unroll
            for (int m = 0; m < 4; ++m) {
                const int rt = ai * HALF + wr * 64 + m * 16 + fr; const float r = S[rt];
                const size_t row = (size_t)(u.pm * BM + rt);
#pragma unroll
                for (int bj = 0; bj < 2; ++bj) {
                    const f32x4 n0 = acc[ai][bj][m][0], n1 = acc[ai][bj][m][1];
                    { u32x4 w; w.x = cvt_pk_bf16(n0[0], n0[1]); w.y = cvt_pk_bf16(n0[2], n0[3]); w.z = cvt_pk_bf16(n1[0], n1[1]); w.w = cvt_pk_bf16(n1[2], n1[3]);
                      *(u32x4*)(xout + row * DM + col0 + bj * HALF) = w; }
                    const f32x4 h0 = (n0 * r) * gsv[bj][0] + shv[bj][0], h1 = (n1 * r) * gsv[bj][1] + shv[bj][1];
                    unsigned w0 = 0u, w1 = 0u;
                    w0 = __builtin_amdgcn_cvt_pk_fp8_f32(h0[0] * f8h, h0[1] * f8h, w0, false); w0 = __builtin_amdgcn_cvt_pk_fp8_f32(h0[2] * f8h, h0[3] * f8h, w0, true);
                    w1 = __builtin_amdgcn_cvt_pk_fp8_f32(h1[0] * f8h, h1[1] * f8h, w1, false); w1 = __builtin_amdgcn_cvt_pk_fp8_f32(h1[2] * f8h, h1[3] * f8h, w1, true);
                    *(unsigned long long*)((unsigned char*)H + row * DM + col0 + bj * HALF) = (unsigned long long)w0 | ((unsigned long long)w1 << 32);
                }
            }
    }
};
struct EpiSwiGLU {
    static constexpr bool PERM = true, AFTER_DRAIN = false;
    bf16_t* O; int nmod; float s;
    const float* SSP; const float* bias;
    float out8;
    __device__ __forceinline__ void operator()(const f32x4 (&acc)[2][2][4][2], const Unit& u, int wr, int wc, int fr, int fq) const {
        const int pnl = nmod ? (u.pn % nmod) : u.pn;
        const int row0 = u.pm * BM + wr * 64 + fr, f0 = pnl * HALF + wc * 32 + 8 * fq;
        const float c1 = -s * LOG2E, kq = 1.f / (s * s * (out8 != 0.f ? out8 : 1.f));
#pragma unroll
        for (int ai = 0; ai < 2; ++ai)
#pragma unroll
            for (int m = 0; m < 4; ++m) {
                const int row = row0 + ai * HALF + m * 16;
                float r[8];
#pragma unroll
                for (int n = 0; n < 2; ++n) {
                    const f32x4 ag = acc[ai][0][m][n], au = acc[ai][1][m][n];
#pragma unroll
                    for (int i = 0; i < 4; ++i) {
                        const float g_ = ag[i], u_ = au[i];
                        const float e_ = __builtin_amdgcn_exp2f(g_ * c1);
                        const float sg_ = __builtin_amdgcn_rcpf(__builtin_fmaf(e_, kq, kq));
                        r[4 * n + i] = (g_ * u_) * sg_;
                    }
                }
                if (out8 != 0.f) {
#pragma unroll
                    for (int i = 0; i < 8; ++i) r[i] = fminf(fmaxf(r[i], -440.f), 440.f);
                    unsigned w0 = 0u, w1 = 0u;
                    w0 = __builtin_amdgcn_cvt_pk_fp8_f32(r[0], r[1], w0, false); w0 = __builtin_amdgcn_cvt_pk_fp8_f32(r[2], r[3], w0, true);
                    w1 = __builtin_amdgcn_cvt_pk_fp8_f32(r[4], r[5], w1, false); w1 = __builtin_amdgcn_cvt_pk_fp8_f32(r[6], r[7], w1, true);
                    *(unsigned long long*)((unsigned char*)O + (size_t)row * DFF + f0) = (unsigned long long)w0 | ((unsigned long long)w1 << 32);
                } else {
                    u32x4 w; w.x = cvt_pk_bf16(r[0], r[1]); w.y = cvt_pk_bf16(r[2], r[3]); w.z = cvt_pk_bf16(r[4], r[5]); w.w = cvt_pk_bf16(r[6], r[7]);
                    *(u32x4*)(O + (size_t)row * DFF + f0) = w;
                }
            }
    }
};
struct EpiStoreBf16 {
    static constexpr bool PERM = true, AFTER_DRAIN = false;
    bf16_t* O; int ldc; int nmod; float s;
    __device__ __forceinline__ void operator()(const f32x4 (&acc)[2][2][4][2], const Unit& u, int wr, int wc, int fr, int fq) const {
        const int pnl = nmod ? (u.pn % nmod) : u.pn;
        const int row0 = u.pm * BM + wr * 64 + fr, col0 = pnl * BM + wc * 32 + 8 * fq;
#pragma unroll
        for (int ai = 0; ai < 2; ++ai)
#pragma unroll
            for (int m = 0; m < 4; ++m) {
                bf16_t* rowp = O + (size_t)(row0 + ai * HALF + m * 16) * ldc + col0;
#pragma unroll
                for (int bj = 0; bj < 2; ++bj) { const f32x4 v0 = acc[ai][bj][m][0] * s, v1 = acc[ai][bj][m][1] * s;
                    u32x4 w; w.x = cvt_pk_bf16(v0[0], v0[1]); w.y = cvt_pk_bf16(v0[2], v0[3]); w.z = cvt_pk_bf16(v1[0], v1[1]); w.w = cvt_pk_bf16(v1[2], v1[3]);
                    *(u32x4*)(rowp + bj * HALF) = w; }
            }
    }
};
struct MoeOrder {
    int nN, ntile, G, c, t1, t2, t3, t4, t5, t6, t7;
    __device__ __forceinline__ bool next(int i, Unit& u) const {
        int tile, pn;
        if ((G & 7) == 0) {
            const int xc = c & 7, nh = nN >> 1, Lx = i * (G >> 3) + (c >> 3), ti = Lx / nh;
            tile = 4 * ti + (xc & 3); pn = (Lx - ti * nh) + nh * (xc >> 2);
            if (tile >= ntile) return false;
        } else {
            const int L = i * G + c; if (L >= ntile * nN) return false;
            tile = L / nN; pn = L - tile * nN;
        }
        const int e = (tile >= t1) + (tile >= t2) + (tile >= t3) + (tile >= t4) + (tile >= t5) + (tile >= t6) + (tile >= t7);
        u.pm = tile; u.pn = e * nN + pn; return true;
    }
    __device__ __forceinline__ void a_ready(const Unit&) const {}
    __device__ __forceinline__ void done(const Unit&) const {}
};
}

#ifndef PROBE_P0
#define PROBE_P0 0
#endif
#ifndef PROBE_ATT
#define PROBE_ATT 0
#endif
#ifndef PROBE_IDX
#define PROBE_IDX 0
#endif
#ifndef PROBE_PROJ
#define PROBE_PROJ 0
#endif
#ifndef PROBE_MUP
#define PROBE_MUP 0
#endif
#ifndef PROBE_MDN
#define PROBE_MDN 0
#endif
#ifndef PROBE_DUP
#define PROBE_DUP 0
#endif
#ifndef PROBE_BAR
#define PROBE_BAR 0
#endif
#ifndef PROBE_NORM
#define PROBE_NORM 0
#endif
#ifndef PROBE_ATT2
#define PROBE_ATT2 0
#endif
#ifndef PROBE_APV
#define PROBE_APV 0
#endif
#ifndef PROBE_MUPL
#define PROBE_MUPL 0
#endif
#ifndef PROBE_GATH
#define PROBE_GATH 0
#endif
#ifndef PROBE_FIN
#define PROBE_FIN 0
#endif
#ifndef PROBE_ROUTE
#define PROBE_ROUTE 0
#endif
#ifndef PROBE_OUT
#define PROBE_OUT 0
#endif
#ifndef PROBE_DDN
#define PROBE_DDN 0
#endif
#ifndef PROBE_BIS
#define PROBE_BIS 0
#endif
#ifndef PROBE_AEXP
#define PROBE_AEXP 0
#endif
#ifndef PROBE_AQK
#define PROBE_AQK 0
#endif
#ifndef PROBE_SEL
#define PROBE_SEL 0
#endif
#ifndef PROBE_SC
#define PROBE_SC 0
#endif
#ifndef PROBE_KM
#define PROBE_KM 0
#endif
constexpr size_t MiB = 1u << 20;
constexpr size_t WS_CTL = 0, CTL_ZERO_BYTES = 64 * 1024;
constexpr size_t WS_MOD = 1 * MiB;
constexpr size_t WS_ROPE = 2 * MiB;
constexpr size_t WS_KMEAN = 4 * MiB;
constexpr size_t WS_LIST = 5 * MiB;
constexpr size_t WS_ENTI = 7 * MiB;
constexpr size_t WS_ENTW = 7 * MiB + 512 * 1024;
constexpr size_t WS_WI = 6 * MiB;
constexpr size_t WS_MASKA = 8 * MiB;
constexpr size_t WS_WIN = 12 * MiB;
constexpr size_t WS_WOUT = 34 * MiB;
constexpr size_t WS_WGU = 42 * MiB;
constexpr size_t WS_WDN = 64 * MiB;
constexpr size_t WS_EGU = 76 * MiB;
constexpr size_t WS_EDN = 252 * MiB;
constexpr size_t WS_X = 340 * MiB;
constexpr size_t WS_H = 404 * MiB;
constexpr size_t WS_PROJ = 436 * MiB;
constexpr size_t WS_Y = 524 * MiB;
constexpr size_t WS_ACT = 556 * MiB;
constexpr size_t WS_ACTM = 436 * MiB;
constexpr size_t WS_R = 623 * MiB;
constexpr size_t WS_HG = 692 * MiB;
constexpr size_t WS_SSP1 = 760 * MiB, WS_SSP2 = 761 * MiB;
constexpr size_t WS_WRT = 760 * MiB;
constexpr size_t WS_RB8 = 760 * MiB + 512 * 1024;
constexpr size_t WS_BIASP = 762 * MiB;
constexpr size_t WS_BIASU = 762 * MiB + 512 * 1024;
constexpr size_t WS_END = 764 * MiB;
constexpr size_t SZ_WIN = (size_t)NP * DM * 2, SZ_WOUT = (size_t)DM * DM * 2, SZ_WGU = (size_t)2 * DFF * DM * 2, SZ_WGU8 = (size_t)2 * DFF * DM, SZ_WDN = (size_t)DM * DFF * 2, SZ_WDN8 = (size_t)DM * DFF;
constexpr int CW_BAR = 4096;

constexpr int RING_BYTES = 131072;
constexpr int MISC_OFF = RING_BYTES + 320;
constexpr int MOE_TB_OFF = RING_BYTES, MOE_CN_OFF = RING_BYTES + 64;
constexpr int LDS_BYTES = 147456;
constexpr int NWAVES = 8, NTHR = 512;

#define GAS __attribute__((address_space(1)))
#define LAS __attribute__((address_space(3)))
typedef unsigned short bf16;
typedef float f32x4 __attribute__((ext_vector_type(4)));
typedef unsigned u32x4 __attribute__((ext_vector_type(4)));
typedef unsigned u32x2 __attribute__((ext_vector_type(2)));
typedef GAS unsigned gu32;

__device__ __forceinline__ unsigned f2bf(float f) { unsigned u = __builtin_bit_cast(unsigned, f); return (u + 0x7fffu + ((u >> 16) & 1u)) >> 16; }
__device__ __forceinline__ unsigned pk2(float lo, float hi) { return f2bf(lo) | (f2bf(hi) << 16); }
__device__ __forceinline__ float bflo(unsigned w) { return __builtin_bit_cast(float, w << 16); }
__device__ __forceinline__ float bfhi(unsigned w) { return __builtin_bit_cast(float, w & 0xffff0000u); }
__device__ __forceinline__ int vzero() { int z; asm volatile("v_mov_b32 %0, 0" : "=v"(z)); return z; }
__device__ __forceinline__ float wave_sum(float v) {
#pragma unroll
    for (int o = 1; o < 64; o <<= 1) v += __shfl_xor(v, o);
    return v;
}

#define XB_TMO      128
#define XB_XCNT(j)  (256  + 64 * (j))
#define XB_XSUB(j)  (1280 + 64 * (j))
#define XB_XGEN(j)  (2304 + 64 * (j))
#define XB_TOP      3328
#define XB_TOPGEN   3392
#define XCD_BAR_WORDS 3456
#define XB_SPIN_CAP (1u << 18)

__device__ __forceinline__ unsigned xb_ld(unsigned* p)              { return __hip_atomic_load(p, __ATOMIC_RELAXED, __HIP_MEMORY_SCOPE_AGENT); }
__device__ __forceinline__ unsigned xb_add(unsigned* p, unsigned v) { return __hip_atomic_fetch_add(p, v, __ATOMIC_RELAXED, __HIP_MEMORY_SCOPE_AGENT); }
__device__ __forceinline__ unsigned xb_xcc_id() { return (unsigned)__builtin_amdgcn_s_getreg((3 << 11) | 20) & 0xFu; }
#define XB_SPIN(cond, bar) do { unsigned _sp = 0; while (cond) { __builtin_amdgcn_s_sleep(1); \
    if ((++_sp & 255u) == 0u) { if (xb_ld(&(bar)[XB_TMO])) break; if (_sp > XB_SPIN_CAP) { atomicAdd(&(bar)[XB_TMO], 1u); break; } } } } while (0)

struct XcdBarrier {
    unsigned* bar; unsigned x;
    volatile LAS unsigned* st;
};

__device__ __forceinline__ XcdBarrier xcd_barrier_post(unsigned* bar, volatile LAS unsigned* st) {
    XcdBarrier b; b.bar = bar; b.x = xb_xcc_id(); b.st = st;
    if (threadIdx.x == 0) (void)xb_add(&bar[XB_XCNT(b.x)], 1u);
    return b;
}
__device__ __forceinline__ void xcd_barrier_complete(unsigned* bar, unsigned x, unsigned& nloc, unsigned& nx) {
    const unsigned G = gridDim.x * gridDim.y * gridDim.z;
    unsigned sum, cnt, mine, sp = 0u;
    for (;;) {
        sum = 0u; cnt = 0u; mine = 0u;
#pragma unroll
        for (unsigned j = 0; j < 16; ++j) { const unsigned c = xb_ld(&bar[XB_XCNT(j)]); sum += c; cnt += (c > 0u) ? 1u : 0u; mine = (j == x) ? c : mine; }
        if (sum == G) break;
        __builtin_amdgcn_s_sleep(1);
        if ((++sp & 255u) == 0u) { if (xb_ld(&bar[XB_TMO])) break; if (sp > XB_SPIN_CAP) { atomicAdd(&bar[XB_TMO], 1u); break; } }
    }
    nloc = mine > 0u ? mine : 1u; nx = cnt > 0u ? cnt : 1u;
}

__device__ __forceinline__ void xcd_barrier(const XcdBarrier& b) {
    asm volatile("s_waitcnt vmcnt(0)" ::: "memory");
    __syncthreads();
    if (threadIdx.x == 0) {
        unsigned* bar = b.bar;
        __builtin_amdgcn_s_waitcnt(0);
        unsigned nloc = b.st[0], nx = b.st[1];
        if (nloc == 0u) { xcd_barrier_complete(bar, b.x, nloc, nx); b.st[0] = nloc; b.st[1] = nx; }
        const unsigned old = xb_add(&bar[XB_XSUB(b.x)], 1u);
        const unsigned gen = old / nloc;
        if (old + 1u == (gen + 1u) * nloc) {
            __builtin_amdgcn_fence(__ATOMIC_RELEASE, "agent");
            asm volatile("s_waitcnt vmcnt(0)" ::: "memory");
            const unsigned og = xb_add(&bar[XB_TOP], 1u);
            const unsigned tg = og / nx;
            if (og + 1u == (tg + 1u) * nx) xb_add(&bar[XB_TOPGEN], 1u);
            else XB_SPIN(xb_ld(&bar[XB_TOPGEN]) == tg, bar);
            __builtin_amdgcn_fence(__ATOMIC_ACQUIRE, "agent");
            xb_add(&bar[XB_XGEN(b.x)], 1u);
            asm volatile("s_waitcnt vmcnt(0)" ::: "memory");
        } else {
            XB_SPIN(xb_ld(&bar[XB_XGEN(b.x)]) == gen, bar);
            __builtin_amdgcn_fence(__ATOMIC_ACQUIRE, "agent");
            asm volatile("s_waitcnt vmcnt(0)" ::: "memory");
        }
    }
    __syncthreads();
}


struct Args {
    const float* x; const float* c; const int* pos; const float* w_in; const float* w_out; const float* dlam; const float* dsub; const float* w_ada; const float* b_ada;
    const float* g_attn; const float* g_ffn; const float* wg; const float* wu; const float* wd; const float* w_router; const float* eg; const float* eu; const float* ed; const float* g_final;
    float* out; unsigned char* ws; int ph_lo, ph_hi;
};

__device__ __forceinline__ unsigned pk_fp8x4(float a, float b, float c, float d) { unsigned w = 0u; w = __builtin_amdgcn_cvt_pk_fp8_f32(a, b, w, false); w = __builtin_amdgcn_cvt_pk_fp8_f32(c, d, w, true); return w; }
constexpr float F8_WSCALE = 64.f, F8_HSCALE = 4.f, F8_ASCALE = 4.f;
template <int MODE, bool F8>
__device__ __forceinline__ void tr_tile(const float* __restrict__ s0, const float* __restrict__ s1, int N, int K, void* __restrict__ dst, int p0, int k0, LAS float* scr, int tid) {
    {
        const int pl = tid & 63, p = p0 + pl, kk = tid >> 6;
        const float* src = s0; int col;
        if (MODE == 0) col = p;
        else if (MODE == 1) col = p < 832 ? p : (p < 2752 ? p + 4 : (p < 2756 ? p - 2752 + 832 : -1));
        else { col = 128 * (p >> 8) + (p & 127); if ((p >> 7) & 1) src = s1; }
        float v[32];
#pragma unroll
        for (int j = 0; j < 32; ++j) v[j] = (col >= 0) ? src[(size_t)(k0 + kk + 8 * j) * N + col] : 0.f;
#pragma unroll
        for (int j = 0; j < 32; ++j) scr[(kk + 8 * j) * 65 + pl] = v[j];
    }
    __syncthreads();
    {
        const int kc = tid & 31;
#pragma unroll
        for (int pass = 0; pass < 4; ++pass) {
            const int p = (tid >> 5) + 16 * pass;
            const LAS float* q = scr + (8 * kc) * 65 + p;
            if (F8) { u32x2 o; o.x = pk_fp8x4(q[0] * F8_WSCALE, q[65] * F8_WSCALE, q[130] * F8_WSCALE, q[195] * F8_WSCALE); o.y = pk_fp8x4(q[260] * F8_WSCALE, q[325] * F8_WSCALE, q[390] * F8_WSCALE, q[455] * F8_WSCALE);
                *(u32x2*)((unsigned char*)dst + (size_t)(p0 + p) * K + k0 + 8 * kc) = o; }
            else { u32x4 o; o.x = pk2(q[0], q[65]); o.y = pk2(q[130], q[195]); o.z = pk2(q[260], q[325]); o.w = pk2(q[390], q[455]);
                *(u32x4*)((bf16*)dst + (size_t)(p0 + p) * K + k0 + 8 * kc) = o; }
        }
    }
    __syncthreads();
}
struct TrItem { const float* s0; const float* s1; void* dst; int N, K, p0, k0, mode, f8; };
__device__ __forceinline__ void tr_load(const TrItem& I, float (&v)[32], int tid) {
    const int pl = tid & 63, p = I.p0 + pl, kk = tid >> 6;
    const float* src = I.s0; int col;
    if (I.mode == 0) col = p;
    else if (I.mode == 1) col = p < 832 ? p : (p < 2752 ? p + 4 : (p < 2756 ? p - 2752 + 832 : -1));
    else { col = 128 * (p >> 8) + (p & 127); if ((p >> 7) & 1) src = I.s1; }
    const float* sp = src + (size_t)(I.k0 + kk) * I.N + (col >= 0 ? col : 0);
    const size_t st = (size_t)8 * I.N;
#pragma unroll
    for (int j = 0; j < 32; ++j) v[j] = sp[j * st];
}
__device__ __forceinline__ void tr_lds_write(const TrItem& I, const float (&v)[32], LAS float* scr, int tid) {
    const int pl = tid & 63, kk = tid >> 6;
    const bool pad = I.mode == 1 && (I.p0 + pl) >= 2756;
#pragma unroll
    for (int j = 0; j < 32; ++j) scr[(kk + 8 * j) * 65 + pl] = pad ? 0.f : v[j];
}
__device__ __forceinline__ void tr_store(const TrItem& I, const LAS float* scr, int tid) {
    const int kc = tid & 31;
#pragma unroll
    for (int pass = 0; pass < 4; ++pass) {
        const int p = (tid >> 5) + 16 * pass;
        const LAS float* q = scr + (8 * kc) * 65 + p;
        if (I.f8) { u32x2 o; o.x = pk_fp8x4(q[0] * F8_WSCALE, q[65] * F8_WSCALE, q[130] * F8_WSCALE, q[195] * F8_WSCALE); o.y = pk_fp8x4(q[260] * F8_WSCALE, q[325] * F8_WSCALE, q[390] * F8_WSCALE, q[455] * F8_WSCALE);
            *(u32x2*)((unsigned char*)I.dst + (size_t)(I.p0 + p) * I.K + I.k0 + 8 * kc) = o; }
        else { u32x4 o; o.x = pk2(q[0], q[65]); o.y = pk2(q[130], q[195]); o.z = pk2(q[260], q[325]); o.w = pk2(q[390], q[455]);
            *(u32x4*)((bf16*)I.dst + (size_t)(I.p0 + p) * I.K + I.k0 + 8 * kc) = o; }
    }
}
typedef const __attribute__((address_space(4))) struct Args* ArgsP;
__device__ __forceinline__ void p0_prologue(ArgsP AP, LAS unsigned char* lds, int wg, int G, int tid) {
    unsigned char* ws = AP->ws;
    LAS float* scr = (LAS float*)lds;
    constexpr int I_IN = 44 * 4, I_OUT = 16 * 4, I_GU = 88 * 4, I_DN = 16 * 11;
    constexpr int N_IN = 4 * I_IN, N_OUT = 4 * I_OUT, N_GU = 2 * I_GU, N_DN = 2 * I_DN, N_EGU = 16 * I_GU, N_EDN = 16 * I_DN;
    constexpr int NITEMS = N_IN + N_OUT + N_GU + N_DN + N_EGU + N_EDN;
    {
        auto decode = [&](int it, TrItem& I) {
            int r = it;
            if (r < N_IN) { const int l = r / I_IN, q = r % I_IN; I = TrItem{AP->w_in + (size_t)l * DM * DIN, nullptr, ws + WS_WIN + l * SZ_WIN, DIN, DM, (q / 4) * 64, (q % 4) * 256, 1, 0}; return; } r -= N_IN;
            if (r < N_OUT) { const int l = r / I_OUT, q = r % I_OUT; I = TrItem{AP->w_out + (size_t)l * DM * DM, nullptr, ws + WS_WOUT + l * SZ_WOUT, DM, DM, (q / 4) * 64, (q % 4) * 256, 0, 0}; return; } r -= N_OUT;
            if (r < N_GU) { const int l = r / I_GU, q = r % I_GU; I = TrItem{AP->wg + (size_t)l * DM * DFF, AP->wu + (size_t)l * DM * DFF, ws + WS_WGU + l * SZ_WGU8, DFF, DM, (q / 4) * 64, (q % 4) * 256, 2, 1}; return; } r -= N_GU;
            if (r < N_DN) { const int l = r / I_DN, q = r % I_DN; I = TrItem{AP->wd + (size_t)l * DFF * DM, nullptr, ws + WS_WDN + l * SZ_WDN8, DM, DFF, (q / 11) * 64, (q % 11) * 256, 0, 1}; return; } r -= N_DN;
            if (r < N_EGU) { const int l = r / I_GU, q = r % I_GU; I = TrItem{AP->eg + (size_t)l * DM * DFF, AP->eu + (size_t)l * DM * DFF, ws + WS_EGU + l * SZ_WGU8, DFF, DM, (q / 4) * 64, (q % 4) * 256, 2, 1}; return; } r -= N_EGU;
            { const int l = r / I_DN, q = r % I_DN; I = TrItem{AP->ed + (size_t)l * DFF * DM, nullptr, ws + WS_EDN + l * SZ_WDN8, DM, DFF, (q / 11) * 64, (q % 11) * 256, 0, 1}; }
        };
        TrItem ia, ib; float va[32], vb[32];
        int it = wg;
        if (it < NITEMS) { decode(it, ia); tr_load(ia, va, tid); }
        if (it + G < NITEMS) { decode(it + G, ib); tr_load(ib, vb, tid); }
        while (it < NITEMS) {
            {   TrItem cur = ia;
                tr_lds_write(cur, va, scr, tid);
                asm volatile("s_waitcnt lgkmcnt(0)" ::: "memory"); __builtin_amdgcn_s_barrier(); asm volatile("" ::: "memory");
                if (it + 2 * G < NITEMS) { decode(it + 2 * G, ia); tr_load(ia, va, tid); }
                tr_store(cur, scr, tid);
                asm volatile("s_waitcnt lgkmcnt(0)" ::: "memory"); __builtin_amdgcn_s_barrier(); asm volatile("" ::: "memory");
            }
            it += G;
            if (it >= NITEMS) break;
            {   TrItem cur = ib;
                tr_lds_write(cur, vb, scr, tid);
                asm volatile("s_waitcnt lgkmcnt(0)" ::: "memory"); __builtin_amdgcn_s_barrier(); asm volatile("" ::: "memory");
                if (it + 2 * G < NITEMS) { decode(it + 2 * G, ib); tr_load(ib, vb, tid); }
                tr_store(cur, scr, tid);
                asm volatile("s_waitcnt lgkmcnt(0)" ::: "memory"); __builtin_amdgcn_s_barrier(); asm volatile("" ::: "memory");
            }
            it += G;
        }
        __syncthreads();
    }
    {
        LAS float* cact = (LAS float*)lds;
        bool have = false;
        for (int it = wg; it < 4 * 48; it += G) {
            if (!have) { for (int i = tid; i < NB * DM; i += NTHR) { const float v = AP->c[i]; cact[i] = v / (1.f + __expf(-v)); } have = true; __syncthreads(); }
            const int l = it / 48, j0 = (it % 48) * 128, cg = tid & 31, ks = tid >> 5;
            const float* w = AP->w_ada + (size_t)l * DM * MODW + j0 + 4 * cg;
            f32x4 acc[8];
#pragma unroll
            for (int b = 0; b < 8; ++b) acc[b] = (f32x4){0.f, 0.f, 0.f, 0.f};
            for (int k0 = ks * 64; k0 < ks * 64 + 64; k0 += 8) {
                f32x4 wv[8];
#pragma unroll
                for (int i = 0; i < 8; ++i) wv[i] = *(const f32x4*)(w + (size_t)(k0 + i) * MODW);
#pragma unroll
                for (int i = 0; i < 8; ++i)
#pragma unroll
                    for (int b = 0; b < 8; ++b) acc[b] += wv[i] * cact[b * DM + k0 + i];
            }
            LAS f32x4* red4 = (LAS f32x4*)(lds + 32768);
#pragma unroll
            for (int b = 0; b < 8; ++b) red4[(ks * 8 + b) * 32 + cg] = acc[b];
            __syncthreads();
            if (tid < 256) {
                const int b = tid >> 5, c = tid & 31;
                f32x4 sum = red4[b * 32 + c];
#pragma unroll
                for (int q = 1; q < 16; ++q) sum += red4[(q * 8 + b) * 32 + c];
                float* mod = (float*)(ws + WS_MOD) + (size_t)l * NB * MODW;
                const f32x4 bias = *(const f32x4*)(AP->b_ada + (size_t)l * MODW + j0 + 4 * c);
                *(f32x4*)(mod + (size_t)b * MODW + j0 + 4 * c) = sum + bias;
            }
            __syncthreads();
        }
    }
    { float* wrt = (float*)(ws + WS_WRT);
      for (int i = wg * NTHR + tid; i < 2 * NE * DM; i += G * NTHR) { const int j = i / (NE * DM), e = (i / DM) % NE, c = i % DM; wrt[i] = AP->w_router[((size_t)j * DM + c) * NE + e]; } }
    {
        float* rope = (float*)(ws + WS_ROPE);
        for (int m = wg * NTHR + tid; m < T; m += G * NTHR) {
            const float p = (float)AP->pos[m];
            float* r = rope + (size_t)m * 24;
            const float inv64[8] = {1.0f, 0.193922758102417f, 0.03760603070259094f, 0.00729266507551074f, 0.001414213445968926f, 0.00027424818836152554f, 5.318296462064609e-05f, 1.0313385246263351e-05f};
            const float inv32[4] = {1.0f, 0.03760603070259094f, 0.001414213445968926f, 5.318296462064609e-05f};
#pragma unroll
            for (int i = 0; i < 8; ++i) { const float a = p * inv64[i]; r[i] = cosf(a); r[8 + i] = sinf(a); }
#pragma unroll
            for (int i = 0; i < 4; ++i) { const float a = p * inv32[i]; r[16 + i] = cosf(a); r[20 + i] = sinf(a); }
        }
    }
}

__device__ __forceinline__ void bias_items(ArgsP AP, unsigned char* ws, LAS unsigned char* lds, int wg, int G, int tid) {
    LAS float* shv = (LAS float*)lds;
    const float* mod = (const float*)(ws + WS_MOD);
    for (int it = wg; it < 44 + 88; it += G) {
        const bool isP = it < 44;
        const int r = isP ? it : it - 44, li = isP ? r / 22 : r / 44, c0 = (isP ? r % 22 : r % 44) * 128;
        const int l = isP ? 2 * li + 1 : 2 * li;
        const float* shsrc = mod + (size_t)l * NB * MODW + (isP ? 0 : 3 * DM);
        for (int i = tid; i < NB * DM; i += NTHR) shv[i] = shsrc[(size_t)(i >> 10) * MODW + (i & 1023)];
        __syncthreads();
        const int cg = tid & 31, ks = tid >> 5, p = c0 + 4 * cg;
        const float* w; size_t pitch; bool valid = true;
        if (isP) { const int sc = p < 832 ? p : (p < 2752 ? p + 4 : (p < 2756 ? p - 2752 + 832 : -1)); valid = sc >= 0; w = AP->w_in + (size_t)l * DM * DIN + (valid ? sc : 0); pitch = DIN; }
        else { const int f = 4 * (p >> 3); w = (((p >> 2) & 1) ? AP->wu : AP->wg) + (size_t)li * DM * DFF + f; pitch = DFF; }
        f32x4 acc[8];
#pragma unroll
        for (int b = 0; b < 8; ++b) acc[b] = (f32x4){0.f, 0.f, 0.f, 0.f};
        for (int k0 = ks * 64; k0 < ks * 64 + 64; k0 += 8) {
            f32x4 wv[8];
#pragma unroll
            for (int i = 0; i < 8; ++i) wv[i] = valid ? *(const f32x4*)(w + (size_t)(k0 + i) * pitch) : (f32x4){0.f, 0.f, 0.f, 0.f};
#pragma unroll
            for (int i = 0; i < 8; ++i)
#pragma unroll
                for (int b = 0; b < 8; ++b) acc[b] += wv[i] * shv[b * DM + k0 + i];
        }
        LAS f32x4* red4 = (LAS f32x4*)(lds + 32768);
#pragma unroll
        for (int b = 0; b < 8; ++b) red4[(ks * 8 + b) * 32 + cg] = acc[b];
        __syncthreads();
        if (tid < 256) {
            const int b = tid >> 5, c = tid & 31;
            f32x4 sum = red4[b * 32 + c];
#pragma unroll
            for (int q = 1; q < 16; ++q) sum += red4[(q * 8 + b) * 32 + c];
            float* out = isP ? (float*)(ws + WS_BIASP) + (size_t)li * NB * NP : (float*)(ws + WS_BIASU) + (size_t)li * NB * 2 * DFF;
            const int N = isP ? NP : 2 * DFF;
            *(f32x4*)(out + (size_t)b * N + c0 + 4 * c) = sum;
        }
        __syncthreads();
    }
}

constexpr int CW_PANEL = 13312;
constexpr int CW_PANEL2 = CW_PANEL + 2048;
constexpr int CW_MOECNT = 12288;
__device__ __forceinline__ int moe_tables(const unsigned* gcnt, LAS int* tb  , LAS int* cn  , int tid) {
    if (tid == 0) { int acc = 0;
        for (int e = 0; e < 8; ++e) { const int c = (int)__hip_atomic_load(gcnt + e, __ATOMIC_RELAXED, __HIP_MEMORY_SCOPE_AGENT); cn[e] = c; tb[e] = acc; acc += (c + 255) >> 8; }
        tb[8] = acc; }
    __syncthreads();
    return __builtin_amdgcn_readfirstlane(tb[8]);
}
__device__ __forceinline__ int moe_expert_of_tile(const LAS int* tb, int tile) {
    int e = 0;
#pragma unroll
    for (int k = 1; k < 8; ++k) e += (tile >= tb[k]) ? 1 : 0;
    return e;
}
__device__ __forceinline__ f32x4 bf4_to_f32(unsigned long long w) { return (f32x4){__builtin_bit_cast(float, (unsigned)w << 16), __builtin_bit_cast(float, (unsigned)w & 0xffff0000u), __builtin_bit_cast(float, (unsigned)(w >> 32) << 16), __builtin_bit_cast(float, (unsigned)(w >> 32) & 0xffff0000u)}; }
__device__ __forceinline__ void bf8_to_f32(u32x4 w, f32x4& lo, f32x4& hi) { lo = (f32x4){bflo(w.x), bfhi(w.x), bflo(w.y), bfhi(w.y)}; hi = (f32x4){bflo(w.z), bfhi(w.z), bflo(w.w), bfhi(w.w)}; }
__device__ __forceinline__ u32x4 f32_to_bf8(f32x4 lo, f32x4 hi) { u32x4 w; w.x = pk2(lo.x, lo.y); w.y = pk2(lo.z, lo.w); w.z = pk2(hi.x, hi.y); w.w = pk2(hi.z, hi.w); return w; }
template <bool COMBINE, bool FINAL, bool OUT8 = false, bool XBF = true>
__device__ __forceinline__ void phase_norm(const void* xin, bf16* xout, const float* g, const float* mod_l, int off_sh, int off_sc, bf16* H, float* out,
                                           const bf16* R, const int* ENTI, const float* ENTW, const float* gate_prev, const LAS int* tb, int gw, int ngw, int lane) {
    const int rpw = T / ngw, m_lo = gw * rpw, m_hi = m_lo + rpw;
    const int b = m_lo >> 11;
    f32x4 gsv[2][2], shv4[2][2], gpv[2][2];
#pragma unroll
    for (int c = 0; c < 2; ++c)
#pragma unroll
        for (int n = 0; n < 2; ++n) { const int col = 8 * lane + 512 * c + 4 * n;
            if (FINAL) gsv[c][n] = *(const f32x4*)(g + col);
            else { gsv[c][n] = *(const f32x4*)(g + col) * (*(const f32x4*)(mod_l + (size_t)b * MODW + off_sc + col) + 1.f); shv4[c][n] = *(const f32x4*)(mod_l + (size_t)b * MODW + off_sh + col); }
            if (COMBINE) gpv[c][n] = *(const f32x4*)(gate_prev + (size_t)b * MODW + col); }
    f32x4 vn[2][2]; u32x4 an[2], cn[2]; float wn0 = 0.f, wn1 = 0.f;
#define PN_LOAD(mm) do { \
        if (XBF) { const u32x4* xr_ = (const u32x4*)((const bf16*)xin + (size_t)(mm) * DM) + lane; _Pragma("unroll") for (int c = 0; c < 2; ++c) bf8_to_f32(xr_[64 * c], vn[c][0], vn[c][1]); } \
        else { const f32x4* xr_ = (const f32x4*)((const float*)xin + (size_t)(mm) * DM) + 2 * lane; _Pragma("unroll") for (int c = 0; c < 2; ++c) { vn[c][0] = xr_[128 * c]; vn[c][1] = xr_[128 * c + 1]; } } \
        if (COMBINE) { const int vz_ = vzero(); \
            const int e0_ = ENTI[(size_t)(mm) * 4 + vz_], p0_ = ENTI[(size_t)(mm) * 4 + 1 + vz_], e1_ = ENTI[(size_t)(mm) * 4 + 2 + vz_], p1_ = ENTI[(size_t)(mm) * 4 + 3 + vz_]; \
            wn0 = ENTW[(size_t)(mm) * 2 + vz_]; wn1 = ENTW[(size_t)(mm) * 2 + 1 + vz_]; \
            const size_t r0_ = (size_t)(256 * tb[e0_] + p0_), r1_ = (size_t)(256 * tb[e1_] + p1_); \
            const u32x4* q0_ = (const u32x4*)(R + r0_ * DM) + lane; const u32x4* q1_ = (const u32x4*)(R + r1_ * DM) + lane; \
            _Pragma("unroll") for (int c = 0; c < 2; ++c) { an[c] = q0_[64 * c]; cn[c] = q1_[64 * c]; } } } while (0)
    PN_LOAD(m_lo);
    for (int m = m_lo; m < m_hi; ++m) {
        f32x4 v[2][2]; u32x4 a2[2], c2[2]; const float w0 = wn0, w1 = wn1; float ss = 0.f;
#pragma unroll
        for (int c = 0; c < 2; ++c) { v[c][0] = vn[c][0]; v[c][1] = vn[c][1]; if (COMBINE) { a2[c] = an[c]; c2[c] = cn[c]; } }
        if (m + 1 < m_hi) PN_LOAD(m + 1);
        if (COMBINE) {
            u32x4* xo = (u32x4*)(xout + (size_t)m * DM) + lane;
#pragma unroll
            for (int c = 0; c < 2; ++c) {
                f32x4 al, ah, cl, ch; bf8_to_f32(a2[c], al, ah); bf8_to_f32(c2[c], cl, ch);
                v[c][0] = v[c][0] + gpv[c][0] * (al * w0 + cl * w1);
                v[c][1] = v[c][1] + gpv[c][1] * (ah * w0 + ch * w1);
                if (!FINAL) xo[64 * c] = f32_to_bf8(v[c][0], v[c][1]);
            }
        }
#pragma unroll
        for (int c = 0; c < 2; ++c)
#pragma unroll
            for (int n = 0; n < 2; ++n) ss += (v[c][n].x * v[c][n].x + v[c][n].y * v[c][n].y) + (v[c][n].z * v[c][n].z + v[c][n].w * v[c][n].w);
        const float rstd = 1.f / sqrtf(wave_sum(ss) * (1.f / DM) + 1e-6f);
        if (FINAL) {
            f32x4* o = (f32x4*)(out + (size_t)m * DM) + 2 * lane;
#pragma unroll
            for (int c = 0; c < 2; ++c) { o[128 * c] = (v[c][0] * rstd) * gsv[c][0]; o[128 * c + 1] = (v[c][1] * rstd) * gsv[c][1]; }
        } else {
#pragma unroll
            for (int c = 0; c < 2; ++c) {
                const f32x4 h0 = (v[c][0] * rstd) * gsv[c][0] + shv4[c][0], h1 = (v[c][1] * rstd) * gsv[c][1] + shv4[c][1];
                if (OUT8) *((unsigned long long*)((unsigned char*)H + (size_t)m * DM) + lane + 64 * c) =
                    (unsigned long long)pk_fp8x4(h0.x * F8_HSCALE, h0.y * F8_HSCALE, h0.z * F8_HSCALE, h0.w * F8_HSCALE) | ((unsigned long long)pk_fp8x4(h1.x * F8_HSCALE, h1.y * F8_HSCALE, h1.z * F8_HSCALE, h1.w * F8_HSCALE) << 32);
                else *((u32x4*)(H + (size_t)m * DM) + lane + 64 * c) = f32_to_bf8(h0, h1);
            }
        }
    }
#undef PN_LOAD
}
__device__ __forceinline__ void phase_norm_route(const bf16* xin, const float* g, const float* mod_l, int off_sh, int off_sc, bf16* H, const float* wr, int* LIST, int* ENTI, float* ENTW, unsigned* gcnt,
                                                 LAS unsigned char* lds, int wg, int G, int tid, int lane, int wave) {
    LAS int* le = (LAS int*)lds;
    LAS int* lp = le + 128;
    LAS float* lw = (LAS float*)(lp + 128);
    LAS unsigned* lcnt = (LAS unsigned*)(lw + 128);
    LAS unsigned* lbase = lcnt + 8;
    for (int chunk = wg; chunk < T / 64; chunk += G) {
        if (tid < 8) lcnt[tid] = 0u;
        __syncthreads();
        f32x4 wra[16], wrb[16];
#pragma unroll
        for (int c = 0; c < 2; ++c)
#pragma unroll
            for (int i = 0; i < 8; ++i) { const int col = 8 * lane + 512 * c + i; wra[8 * c + i] = *(const f32x4*)(wr + (size_t)col * 8); wrb[8 * c + i] = *(const f32x4*)(wr + (size_t)col * 8 + 4); }
        f32x4 gsv[2][2], shv4[2][2];
        { const int b0 = (chunk * 64) >> 11;
#pragma unroll
          for (int c = 0; c < 2; ++c)
#pragma unroll
            for (int n = 0; n < 2; ++n) { const int col = 8 * lane + 512 * c + 4 * n; gsv[c][n] = *(const f32x4*)(g + col) * (*(const f32x4*)(mod_l + (size_t)b0 * MODW + off_sc + col) + 1.f); shv4[c][n] = *(const f32x4*)(mod_l + (size_t)b0 * MODW + off_sh + col); } }
        for (int rr = 0; rr < 8; ++rr) {
            const int rl = wave * 8 + rr, m = chunk * 64 + rl;
            const u32x4* xr = (const u32x4*)(xin + (size_t)m * DM) + lane;
            f32x4 v[2][2]; float ss = 0.f;
#pragma unroll
            for (int c = 0; c < 2; ++c) { bf8_to_f32(xr[64 * c], v[c][0], v[c][1]);
#pragma unroll
                for (int n = 0; n < 2; ++n) ss += (v[c][n].x * v[c][n].x + v[c][n].y * v[c][n].y) + (v[c][n].z * v[c][n].z + v[c][n].w * v[c][n].w); }
            const float rstd = 1.f / sqrtf(wave_sum(ss) * (1.f / DM) + 1e-6f);
            float pe[8];
#pragma unroll
            for (int e = 0; e < 8; ++e) pe[e] = 0.f;
#pragma unroll
            for (int c = 0; c < 2; ++c) {
                const f32x4 h0 = (v[c][0] * rstd) * gsv[c][0] + shv4[c][0], h1 = (v[c][1] * rstd) * gsv[c][1] + shv4[c][1];
                *((unsigned long long*)((unsigned char*)H + (size_t)m * DM) + lane + 64 * c) =
                    (unsigned long long)pk_fp8x4(h0.x * F8_HSCALE, h0.y * F8_HSCALE, h0.z * F8_HSCALE, h0.w * F8_HSCALE) | ((unsigned long long)pk_fp8x4(h1.x * F8_HSCALE, h1.y * F8_HSCALE, h1.z * F8_HSCALE, h1.w * F8_HSCALE) << 32);
                const float hv[8] = {h0.x, h0.y, h0.z, h0.w, h1.x, h1.y, h1.z, h1.w};
#pragma unroll
                for (int i = 0; i < 8; ++i) { const f32x4 w0 = wra[8 * c + i], w1 = wrb[8 * c + i];
                    pe[0] += hv[i] * w0.x; pe[1] += hv[i] * w0.y; pe[2] += hv[i] * w0.z; pe[3] += hv[i] * w0.w; pe[4] += hv[i] * w1.x; pe[5] += hv[i] * w1.y; pe[6] += hv[i] * w1.z; pe[7] += hv[i] * w1.w; }
            }
            {
                const bool b5 = lane & 32, b4 = lane & 16, b3 = lane & 8;
                float k0 = b5 ? pe[4] : pe[0], k1 = b5 ? pe[5] : pe[1], k2 = b5 ? pe[6] : pe[2], k3 = b5 ? pe[7] : pe[3];
                k0 += __shfl_xor(b5 ? pe[0] : pe[4], 32); k1 += __shfl_xor(b5 ? pe[1] : pe[5], 32); k2 += __shfl_xor(b5 ? pe[2] : pe[6], 32); k3 += __shfl_xor(b5 ? pe[3] : pe[7], 32);
                float m0 = b4 ? k2 : k0, m1 = b4 ? k3 : k1;
                m0 += __shfl_xor(b4 ? k0 : k2, 16); m1 += __shfl_xor(b4 ? k1 : k3, 16);
                float r0 = b3 ? m1 : m0;
                r0 += __shfl_xor(b3 ? m0 : m1, 8);
                r0 += __shfl_xor(r0, 4); r0 += __shfl_xor(r0, 2); r0 += __shfl_xor(r0, 1);
#pragma unroll
                for (int e = 0; e < 8; ++e) pe[e] = __builtin_bit_cast(float, __builtin_amdgcn_readlane(__builtin_bit_cast(int, r0), 8 * e));
            }
            int i0 = 0; float v0 = pe[0];
#pragma unroll
            for (int e = 1; e < 8; ++e) if (pe[e] > v0) { v0 = pe[e]; i0 = e; }
            int i1 = -1; float v1 = -INFINITY;
#pragma unroll
            for (int e = 0; e < 8; ++e) if (e != i0 && pe[e] > v1) { v1 = pe[e]; i1 = e; }
            const float e1 = __expf(v1 - v0), w0 = 1.f / (1.f + e1), w1 = e1 / (1.f + e1);
            if (lane == 0) {
                le[2 * rl] = i0; le[2 * rl + 1] = i1; lw[2 * rl] = w0; lw[2 * rl + 1] = w1;
                lp[2 * rl] = (int)__hip_atomic_fetch_add(lcnt + i0, 1u, __ATOMIC_RELAXED, __HIP_MEMORY_SCOPE_WORKGROUP);
                lp[2 * rl + 1] = (int)__hip_atomic_fetch_add(lcnt + i1, 1u, __ATOMIC_RELAXED, __HIP_MEMORY_SCOPE_WORKGROUP);
            }
        }
        __syncthreads();
        if (tid < 8) lbase[tid] = __hip_atomic_fetch_add(gcnt + tid, lcnt[tid], __ATOMIC_RELAXED, __HIP_MEMORY_SCOPE_AGENT);
        __syncthreads();
        if (tid < 128) {
            const int m = chunk * 64 + (tid >> 1), k = tid & 1, e = le[tid], p = (int)lbase[e] + lp[tid];
            LIST[(size_t)e * T + p] = m; ENTI[(size_t)m * 4 + 2 * k] = e; ENTI[(size_t)m * 4 + 2 * k + 1] = p; ENTW[(size_t)m * 2 + k] = lw[tid];
        }
        __syncthreads();
    }
}
__device__ __forceinline__ void phase_moe_gather(const bf16* H, bf16* HG, const int* LIST, const LAS int* tb, const LAS int* cn, int ntile, int gw, int ngw, int lane) {
    for (int row = gw; row < ntile * 256; row += ngw) {
        const int tile = row >> 8, e = moe_expert_of_tile(tb, tile), p = row - 256 * tb[e];
        u32x4 a = {0u, 0u, 0u, 0u};
        if (p < cn[e]) { const int src = LIST[(size_t)e * T + p + vzero()]; a = *((const u32x4*)((const unsigned char*)H + (size_t)src * DM) + lane); }
        *((u32x4*)((unsigned char*)HG + (size_t)row * DM) + lane) = a;
    }
}

__device__ __forceinline__ unsigned ord_key(float s) { if (s == 0.f) s = 0.f; const unsigned u = __builtin_bit_cast(unsigned, s); return (u & 0x80000000u) ? ~u : (u | 0x80000000u); }
__device__ __forceinline__ void idx_unit(int m, const bf16* __restrict__ PROJ, const float* __restrict__ WI, unsigned long long* MASKA, LAS unsigned char* lds, int tid, int lane, int wave) {
    const int b = m >> 11, t = m & 2047;
    unsigned long long* mrow = MASKA + (size_t)m * 32;
    if (t < 256) {
        if (tid < 32) { const int lo = tid * 64; mrow[tid] = (t >= lo + 63) ? ~0ull : (t < lo ? 0ull : ((2ull << (t - lo)) - 1ull)); }
        return;
    }
    LAS float* qs = (LAS float*)lds;
    LAS unsigned* cnt = (LAS unsigned*)(lds + 1024);
    LAS unsigned* cnt2 = (LAS unsigned*)(lds + 1024 + 64);
    LAS unsigned long long* tiebm = (LAS unsigned long long*)(lds + 2048);
    if (tid < 256) { const unsigned short q = PROJ[(size_t)m * NP + C_QI + tid]; qs[tid] = __builtin_bit_cast(float, (unsigned)q << 16); }
    const f32x4 wv = *(const f32x4*)(WI + (size_t)m * 4 + vzero());
    __syncthreads();
    unsigned u[4];
#pragma unroll
    for (int j = 0; j < 4; ++j) {
        const int s = tid + 512 * j;
        u[j] = 0u;
        if (s <= t) {
            const u32x4* kp = (const u32x4*)(PROJ + (size_t)(b * SEQ + s) * NP + C_KI);
            float a0 = 0.f, a1 = 0.f, a2 = 0.f, a3 = 0.f;
#pragma unroll
            for (int c = 0; c < 8; ++c) {
                const u32x4 kw = kp[c];
                float kf[8] = {bflo(kw.x), bfhi(kw.x), bflo(kw.y), bfhi(kw.y), bflo(kw.z), bfhi(kw.z), bflo(kw.w), bfhi(kw.w)};
#pragma unroll
                for (int i = 0; i < 8; ++i) { const int d = c * 8 + i; a0 += qs[d] * kf[i]; a1 += qs[64 + d] * kf[i]; a2 += qs[128 + d] * kf[i]; a3 += qs[192 + d] * kf[i]; }
            }
            const float sc = wv.x * fmaxf(a0, 0.f) + wv.y * fmaxf(a1, 0.f) + wv.z * fmaxf(a2, 0.f) + wv.w * fmaxf(a3, 0.f);
            u[j] = ord_key(sc);
        }
    }
    unsigned thr = 0u;
    for (int bit = 31; bit >= 0; --bit) {
        const unsigned cand = thr | (1u << bit);
        int c = 0;
#pragma unroll
        for (int j = 0; j < 4; ++j) c += __popcll(__ballot(u[j] >= cand));
        if (lane == 0) cnt[(bit & 1) * 8 + wave] = (unsigned)c;
        __syncthreads();
        unsigned tot = 0;
#pragma unroll
        for (int w = 0; w < 8; ++w) tot += cnt[(bit & 1) * 8 + w];
        if (tot >= 256u) thr = cand;
    }
    {
        int c = 0;
#pragma unroll
        for (int j = 0; j < 4; ++j) { c += __popcll(__ballot(u[j] > thr)); const unsigned long long bm = __ballot(u[j] == thr); if (lane == 0) tiebm[8 * j + wave] = bm; }
        if (lane == 0) cnt2[wave] = (unsigned)c;
        __syncthreads();
    }
    unsigned ngt = 0;
#pragma unroll
    for (int w = 0; w < 8; ++w) ngt += cnt2[w];
    const int need = 256 - (int)ngt;
#pragma unroll
    for (int j = 0; j < 4; ++j) {
        const int s = tid + 512 * j;
        bool sel = u[j] > thr;
        if (u[j] == thr) {
            const int wi = 8 * j + wave; int rank = 0;
            for (int w2 = 0; w2 < wi; ++w2) rank += __popcll(tiebm[w2]);
            rank += __popcll(tiebm[wi] & ((1ull << lane) - 1ull));
            sel = rank < need;
        }
        const unsigned long long bits = __ballot(sel && (s <= t));
        if (lane == 0) mrow[8 * j + wave] = bits;
    }
    __syncthreads();
}
typedef short ix_bf16x8 __attribute__((ext_vector_type(8)));
typedef float ix_f32x16 __attribute__((ext_vector_type(16)));
template <int NQ4>
__device__ __forceinline__ void sel_search(const unsigned (&ua)[32], const unsigned (&ub)[32], unsigned& thrA_, unsigned& thrB_, int& cgeA_, int& cgeB_) {
    unsigned thrA = 0u, thrB = 0u; int cgeA = 0, cgeB = 0; bool doneA = false, doneB = false;
#pragma unroll 1
    for (int bit = 31; bit >= 0 && !(doneA && doneB); --bit) {
        const unsigned candA = thrA | (1u << bit), candB = thrB | (1u << bit);
        unsigned cla = 0u, clb = 0u;
#pragma unroll
        for (int j0 = 0; j0 < 4 * NQ4; j0 += 4) {
            unsigned long long tp;
            asm volatile(
                "v_cmp_le_u32_e32 vcc, %3, %5\n\tv_cmp_le_u32_e64 %2, %4, %9\n\tv_addc_co_u32_e32 %0, vcc, 0, %0, vcc\n\tv_addc_co_u32_e64 %1, %2, 0, %1, %2\n\t"
                "v_cmp_le_u32_e32 vcc, %3, %6\n\tv_cmp_le_u32_e64 %2, %4, %10\n\tv_addc_co_u32_e32 %0, vcc, 0, %0, vcc\n\tv_addc_co_u32_e64 %1, %2, 0, %1, %2\n\t"
                "v_cmp_le_u32_e32 vcc, %3, %7\n\tv_cmp_le_u32_e64 %2, %4, %11\n\tv_addc_co_u32_e32 %0, vcc, 0, %0, vcc\n\tv_addc_co_u32_e64 %1, %2, 0, %1, %2\n\t"
                "v_cmp_le_u32_e32 vcc, %3, %8\n\tv_cmp_le_u32_e64 %2, %4, %12\n\tv_addc_co_u32_e32 %0, vcc, 0, %0, vcc\n\tv_addc_co_u32_e64 %1, %2, 0, %1, %2"
                : "+v"(cla), "+v"(clb), "=&s"(tp)
                : "s"(candA), "s"(candB), "v"(ua[j0]), "v"(ua[j0 + 1]), "v"(ua[j0 + 2]), "v"(ua[j0 + 3]),
                  "v"(ub[j0]), "v"(ub[j0 + 1]), "v"(ub[j0 + 2]), "v"(ub[j0 + 3]) : "vcc");
        }
        int xa = (int)cla, xb = (int)clb;
        xa += __builtin_amdgcn_update_dpp(0, xa, 0xB1, 0xF, 0xF, true);  xb += __builtin_amdgcn_update_dpp(0, xb, 0xB1, 0xF, 0xF, true);
        xa += __builtin_amdgcn_update_dpp(0, xa, 0x4E, 0xF, 0xF, true);  xb += __builtin_amdgcn_update_dpp(0, xb, 0x4E, 0xF, 0xF, true);
        xa += __builtin_amdgcn_update_dpp(0, xa, 0x141, 0xF, 0xF, true); xb += __builtin_amdgcn_update_dpp(0, xb, 0x141, 0xF, 0xF, true);
        xa += __builtin_amdgcn_update_dpp(0, xa, 0x140, 0xF, 0xF, true); xb += __builtin_amdgcn_update_dpp(0, xb, 0x140, 0xF, 0xF, true);
        const int cA = __builtin_amdgcn_readlane(xa, 0) + __builtin_amdgcn_readlane(xa, 16) + __builtin_amdgcn_readlane(xa, 32) + __builtin_amdgcn_readlane(xa, 48);
        const int cB = __builtin_amdgcn_readlane(xb, 0) + __builtin_amdgcn_readlane(xb, 16) + __builtin_amdgcn_readlane(xb, 32) + __builtin_amdgcn_readlane(xb, 48);
        if (!doneA && cA >= 256) { thrA = candA; cgeA = cA; if (cA == 256) doneA = true; }
        if (!doneB && cB >= 256) { thrB = candB; cgeB = cB; if (cB == 256) doneB = true; }
    }
    thrA_ = thrA; thrB_ = thrB; cgeA_ = cgeA; cgeB_ = cgeB;
}
__device__ __forceinline__ void idx_unit16(int u16, const bf16* __restrict__ PROJ, const float* __restrict__ WI, unsigned long long* MASKA, LAS unsigned char* lds, int tid, int lane, int wave) {
    const int m0 = u16 * 16, b = m0 >> 11, t0 = m0 & 2047;
    if (t0 < 256) {
#pragma unroll
        for (int qq = 0; qq < 2; ++qq) { const int t = t0 + 2 * wave + qq; const int lo = lane * 64;
            if (lane < 32) MASKA[(size_t)(m0 + 2 * wave + qq) * 32 + lane] = (t >= lo + 63) ? ~0ull : (t < lo ? 0ull : ((2ull << (t - lo)) - 1ull)); }
        return;
    }
    LAS float* sc = (LAS float*)lds;
    const int r = lane & 31, h = lane >> 5;
    {
        ix_bf16x8 qa[2][4]; float wq[2][4][4];
#pragma unroll
        for (int rb = 0; rb < 2; ++rb) {
            const bf16* qp = PROJ + (size_t)(m0 + rb * 8 + (r >> 2)) * NP + C_QI + (r & 3) * 64 + 8 * h;
#pragma unroll
            for (int s = 0; s < 4; ++s) qa[rb][s] = *(const ix_bf16x8*)(qp + 16 * s);
#pragma unroll
            for (int g = 0; g < 4; ++g) { const f32x4 w = *(const f32x4*)(WI + (size_t)(m0 + rb * 8 + 2 * g + h) * 4);
                wq[rb][g][0] = w.x; wq[rb][g][1] = w.y; wq[rb][g][2] = w.z; wq[rb][g][3] = w.w; }
        }
        const int nkb = ((t0 + 15) >> 5) + 1;
        for (int kb0 = wave; kb0 < nkb; kb0 += 32) {
            ix_bf16x8 kf[4][4];
#pragma unroll
            for (int i = 0; i < 4; ++i) { const int kb = kb0 + 8 * i;
                if (kb < nkb) { const bf16* kp = PROJ + (size_t)(b * SEQ + kb * 32 + r) * NP + C_KI + 8 * h;
#pragma unroll
                    for (int s = 0; s < 4; ++s) kf[i][s] = *(const ix_bf16x8*)(kp + 16 * s); } }
#pragma unroll
            for (int i = 0; i < 4; ++i) { const int kb = kb0 + 8 * i;
                if (kb < nkb) { const int key = kb * 32 + r;
#pragma unroll
                    for (int rb = 0; rb < 2; ++rb) {
                        ix_f32x16 acc = {};
#pragma unroll
                        for (int s = 0; s < 4; ++s) acc = __builtin_amdgcn_mfma_f32_32x32x16_bf16(qa[rb][s], kf[i][s], acc, 0, 0, 0);
#pragma unroll
                        for (int g = 0; g < 4; ++g) {
                            const float v = wq[rb][g][0] * fmaxf(acc[4 * g], 0.f) + wq[rb][g][1] * fmaxf(acc[4 * g + 1], 0.f) + wq[rb][g][2] * fmaxf(acc[4 * g + 2], 0.f) + wq[rb][g][3] * fmaxf(acc[4 * g + 3], 0.f);
                            sc[(rb * 8 + 2 * g + h) * 2048 + key] = v;
                        }
                    } } }
        }
    }
    __syncthreads();
    {
        const int qlA = 2 * wave, qlB = qlA + 1, tA = t0 + qlA, tB = tA + 1;
        const int nj = (tB >> 6) + 1;
        unsigned ua[32], ub[32];
#pragma unroll
        for (int j = 0; j < 32; ++j) { ua[j] = 0u; ub[j] = 0u; }
#pragma unroll
        for (int j0 = 0; j0 < 32; j0 += 8) if (j0 < nj) {
#pragma unroll
            for (int k = 0; k < 8; ++k) { const int key = 64 * (j0 + k) + lane;
                const float va = sc[qlA * 2048 + (key < tA ? key : tA)], vb = sc[qlB * 2048 + (key < tB ? key : tB)];
                ua[j0 + k] = (key <= tA) ? ord_key(va) : 0u; ub[j0 + k] = (key <= tB) ? ord_key(vb) : 0u; }
        }
        unsigned thrA = 0u, thrB = 0u; int cgeA = 0, cgeB = 0;
        switch ((nj + 3) >> 2) {
            case 2: sel_search<2>(ua, ub, thrA, thrB, cgeA, cgeB); break;
            case 3: sel_search<3>(ua, ub, thrA, thrB, cgeA, cgeB); break;
            case 4: sel_search<4>(ua, ub, thrA, thrB, cgeA, cgeB); break;
            case 5: sel_search<5>(ua, ub, thrA, thrB, cgeA, cgeB); break;
            case 6: sel_search<6>(ua, ub, thrA, thrB, cgeA, cgeB); break;
            case 7: sel_search<7>(ua, ub, thrA, thrB, cgeA, cgeB); break;
            default: sel_search<8>(ua, ub, thrA, thrB, cgeA, cgeB); break;
        }
#pragma unroll 1
        for (int qq = 0; qq < 2; ++qq) {
            const unsigned thr = qq ? thrB : thrA; const int cge = qq ? cgeB : cgeA, ql = qq ? qlB : qlA;
            unsigned long long myword = 0ull;
            if (cge == 256) {
#pragma unroll
                for (int j = 0; j < 32; ++j) { const unsigned uj = qq ? ub[j] : ua[j]; const unsigned long long word = __ballot(uj >= thr); if (lane == j) myword = word; }
            } else {
                int ngt = 0;
#pragma unroll
                for (int j = 0; j < 32; ++j) { const unsigned uj = qq ? ub[j] : ua[j]; ngt += __popcll(__ballot(uj > thr)); }
                const int need = 256 - ngt;
                int base = 0;
#pragma unroll
                for (int j = 0; j < 32; ++j) {
                    const unsigned uj = qq ? ub[j] : ua[j];
                    const unsigned long long tb = __ballot(uj == thr);
                    const int below = (int)__builtin_amdgcn_mbcnt_hi((unsigned)(tb >> 32), __builtin_amdgcn_mbcnt_lo((unsigned)tb, 0u));
                    const bool sel = (uj > thr) || (uj == thr && (base + below) < need);
                    const unsigned long long word = __ballot(sel);
                    if (lane == j) myword = word;
                    base += __popcll(tb);
                }
            }
            if (lane < 32) MASKA[(size_t)(m0 + ql) * 32 + lane] = myword;
        }
    }
    __syncthreads();
}
__device__ __forceinline__ void kmean_unit(int it, const bf16* __restrict__ PROJ, float* KMEAN, LAS unsigned char* lds, int tid) {
    const int b = it / 48, h = (it % 48) / 8, n = it % 8;
    LAS float* red = (LAS float*)lds;
    const int ch = tid & 7, rs = tid >> 3;
    const bf16* kp = PROJ + (size_t)(b * SEQ + n * 256 + rs) * NP + C_KC + h * 64 + 8 * ch;
    u32x4 w[4];
#pragma unroll
    for (int i = 0; i < 4; ++i) w[i] = *(const u32x4*)(kp + (size_t)(64 * i) * NP);
    f32x4 lo = {0.f, 0.f, 0.f, 0.f}, hi = lo;
#pragma unroll
    for (int i = 0; i < 4; ++i) { f32x4 l_, h_; bf8_to_f32(w[i], l_, h_); lo += l_; hi += h_; }
    *(LAS f32x4*)(red + rs * 64 + 8 * ch) = lo; *(LAS f32x4*)(red + rs * 64 + 8 * ch + 4) = hi;
    __syncthreads();
    if (tid < 64) { float a = 0.f;
#pragma unroll 16
        for (int p = 0; p < 64; ++p) a += red[p * 64 + tid];
        KMEAN[(size_t)it * 64 + tid] = a * (1.f / 256.f); }
    __syncthreads();
}

template <int DQ, int KIND>
__device__ __forceinline__ void attn_naive_task(int b, int qb, int qcol, int kcol, int vcol, const bf16* __restrict__ PROJ, const unsigned long long* __restrict__ MASKA, const float* __restrict__ kmean  ,
                                                bf16* yout  , float* dout  , int lane) {
    const int t = qb * 64 + lane; const size_t m = (size_t)b * SEQ + t; const int vz = vzero();
    float q[DQ], o[64];
    {
        const u32x4* qp = (const u32x4*)(PROJ + m * NP + qcol);
#pragma unroll
        for (int c = 0; c < DQ / 8; ++c) { const u32x4 w = qp[c]; q[8 * c] = bflo(w.x); q[8 * c + 1] = bfhi(w.x); q[8 * c + 2] = bflo(w.y); q[8 * c + 3] = bfhi(w.y); q[8 * c + 4] = bflo(w.z); q[8 * c + 5] = bfhi(w.z); q[8 * c + 6] = bflo(w.w); q[8 * c + 7] = bfhi(w.w); }
    }
#pragma unroll
    for (int d = 0; d < 64; ++d) o[d] = 0.f;
    float mx = -1e30f, l = 0.f;
    unsigned selb = 0u;
    if (KIND == 2) {
        const int npast = t >> 8;
        float gt[8];
#pragma unroll
        for (int n = 0; n < 8; ++n) { float a = 0.f;
#pragma unroll
            for (int d = 0; d < 64; ++d) a += q[d] * kmean[n * 64 + d + vz];
            asm volatile("" : "+v"(a) :: "memory"); gt[n] = a; }
#pragma unroll
        for (int n = 0; n < 8; ++n) { int rank = 0;
#pragma unroll
            for (int j = 0; j < 8; ++j) rank += (j < npast && (gt[j] > gt[n] || (gt[j] == gt[n] && j < n))) ? 1 : 0;
            if (n < npast && rank < 3) selb |= 1u << n; }
    }
    const unsigned long long* mrow = MASKA + m * 32;
    unsigned long long mword = 0ull;
    const int send = qb * 64 + 63;
    for (int s = 0; s <= send; ++s) {
        if (KIND == 0) { if ((s & 63) == 0) mword = mrow[s >> 6]; }
        bool valid = s <= t;
        if (KIND == 0) valid = valid && ((mword >> (s & 63)) & 1ull);
        if (KIND == 2) valid = valid && (((s >> 8) == (t >> 8)) || ((selb >> (s >> 8)) & 1u));
        if (!__any(valid)) continue;
        const bf16* krow = PROJ + ((size_t)b * SEQ + s) * NP + vz;
        float sc = 0.f;
        {
            const u32x4* kp = (const u32x4*)(krow + kcol);
#pragma unroll
            for (int c = 0; c < DQ / 8; ++c) { const u32x4 w = kp[c];
                sc += q[8 * c] * bflo(w.x) + q[8 * c + 1] * bfhi(w.x) + q[8 * c + 2] * bflo(w.y) + q[8 * c + 3] * bfhi(w.y) + q[8 * c + 4] * bflo(w.z) + q[8 * c + 5] * bfhi(w.z) + q[8 * c + 6] * bflo(w.w) + q[8 * c + 7] * bfhi(w.w); }
        }
        if (valid) {
            if (sc > mx) { const float corr = __builtin_amdgcn_exp2f(mx - sc); l *= corr;
#pragma unroll
                for (int d = 0; d < 64; ++d) o[d] *= corr;
                mx = sc; }
            const float p = __builtin_amdgcn_exp2f(sc - mx);
            l += p;
            const u32x4* vp = (const u32x4*)(krow + vcol);
#pragma unroll
            for (int c = 0; c < 8; ++c) { const u32x4 w = vp[c];
                o[8 * c] += p * bflo(w.x); o[8 * c + 1] += p * bfhi(w.x); o[8 * c + 2] += p * bflo(w.y); o[8 * c + 3] += p * bfhi(w.y); o[8 * c + 4] += p * bflo(w.z); o[8 * c + 5] += p * bfhi(w.z); o[8 * c + 6] += p * bflo(w.w); o[8 * c + 7] += p * bfhi(w.w); }
        }
    }
    const float rl = 1.f / l;
    if (KIND == 1) {
        f32x4* dp = (f32x4*)(dout + m * 512);
#pragma unroll
        for (int c = 0; c < 16; ++c) dp[c] = (f32x4){o[4 * c] * rl, o[4 * c + 1] * rl, o[4 * c + 2] * rl, o[4 * c + 3] * rl};
    } else {
        u32x4* yp = (u32x4*)(yout + m * DM);
#pragma unroll
        for (int c = 0; c < 8; ++c) { u32x4 w; w.x = pk2(o[8 * c] * rl, o[8 * c + 1] * rl); w.y = pk2(o[8 * c + 2] * rl, o[8 * c + 3] * rl); w.z = pk2(o[8 * c + 4] * rl, o[8 * c + 5] * rl); w.w = pk2(o[8 * c + 6] * rl, o[8 * c + 7] * rl); yp[c] = w; }
    }
}
__device__ __forceinline__ void phase_attn_naive(const bf16* PROJ, const unsigned long long* MASKA, const float* KMEAN, bf16* Y, float* DTMP, int gw, int ngw, int lane) {
    for (int id = gw; id < 32 * 160; id += ngw) {
        const int qb = 31 - id / 160, r = id % 160;
        if (r < 48) { const int b = r / 6, h = r % 6; attn_naive_task<64, 0>(b, qb, C_QA + h * 64, C_KA, C_VA, PROJ, MASKA, nullptr, Y + h * 64, nullptr, lane); }
        else if (r < 112) { const int r2 = r - 48, b = r2 / 8, hc = r2 % 8; attn_naive_task<32, 1>(b, qb, C_QB + hc * 32, C_KB + hc * 32, C_VB + (hc >> 1) * 64, PROJ, MASKA, nullptr, nullptr, DTMP + hc * 64, lane); }
        else { const int r2 = r - 112, b = r2 / 6, h = r2 % 6; attn_naive_task<64, 2>(b, qb, C_QC + h * 64, C_KC + h * 64, C_VC + h * 64, PROJ, MASKA, KMEAN + (size_t)(b * 6 + h) * 512, Y + 640 + h * 64, nullptr, lane); }
    }
}
__device__ __forceinline__ void phase_diff_combine(const float* DTMP, const float* dlam_l, const float* dsub_l, float lam_init, bf16* Y, int gw, int ngw, int lane) {
    float sa = 0.f, sb = 0.f;
    if (lane < 32) { sa = dlam_l[lane] * dlam_l[32 + lane]; sb = dlam_l[64 + lane] * dlam_l[96 + lane]; }
    const float lam = expf(wave_sum(sa)) - expf(wave_sum(sb)) + lam_init;
    const float gs = dsub_l[lane] * (1.f - lam_init);
    for (int m = gw; m < T; m += ngw) {
#pragma unroll
        for (int h = 0; h < 4; ++h) {
            const float o = DTMP[(size_t)m * 512 + (2 * h) * 64 + lane] - lam * DTMP[(size_t)m * 512 + (2 * h + 1) * 64 + lane];
            const float ss = wave_sum(o * o);
            const float y = o * (1.f / sqrtf(ss * (1.f / 64.f) + 1e-5f)) * gs;
            Y[(size_t)m * DM + 384 + h * 64 + lane] = (bf16)f2bf(y);
        }
    }
}

__device__ const unsigned short ATT_UNITS[1024] = {
    1080, 1081, 1082, 1083, 1208, 1209, 1210, 1211, 1336, 1337, 1338, 1339, 1464, 1465, 1466, 1467,
    1592, 1593, 1594, 1595, 1720, 1721, 1722, 1723, 1848, 1849, 1850, 1851, 1976, 1977, 1978, 1979,
    1072, 1073, 1074, 1075, 1200, 1201, 1202, 1203, 1328, 1329, 1330, 1331, 1456, 1457, 1458, 1459,
    1584, 1585, 1586, 1587, 1712, 1713, 1714, 1715, 1840, 1841, 1842, 1843, 1968, 1969, 1970, 1971,
    1064, 1065, 1066, 1067, 1192, 1193, 1194, 1195, 1320, 1321, 1322, 1323, 1448, 1449, 1450, 1451,
    1576, 1577, 1578, 1579, 1704, 1705, 1706, 1707, 1832, 1833, 1834, 1835, 1960, 1961, 1962, 1963,
    120, 121, 122, 248, 249, 250, 376, 377, 378, 504, 505, 506, 632, 633, 634, 760,
    761, 762, 888, 889, 890, 1016, 1017, 1018, 2104, 2105, 2106, 2107, 2108, 2109, 2232, 2233,
    2234, 2235, 2236, 2237, 2360, 2361, 2362, 2363, 2364, 2365, 2488, 2489, 2490, 2491, 2492, 2493,
    2616, 2617, 2618, 2619, 2620, 2621, 2744, 2745, 2746, 2747, 2748, 2749, 2872, 2873, 2874, 2875,
    2876, 2877, 3000, 3001, 3002, 3003, 3004, 3005, 112, 113, 114, 240, 241, 242, 368, 369,
    370, 496, 497, 498, 624, 625, 626, 752, 753, 754, 880, 881, 882, 1008, 1009, 1010,
    1056, 1057, 1058, 1059, 1184, 1185, 1186, 1187, 1312, 1313, 1314, 1315, 1440, 1441, 1442, 1443,
    1568, 1569, 1570, 1571, 1696, 1697, 1698, 1699, 1824, 1825, 1826, 1827, 1952, 1953, 1954, 1955,
    104, 105, 106, 232, 233, 234, 360, 361, 362, 488, 489, 490, 616, 617, 618, 744,
    745, 746, 872, 873, 874, 1000, 1001, 1002, 2096, 2097, 2098, 2099, 2100, 2101, 2224, 2225,
    2226, 2227, 2228, 2229, 2352, 2353, 2354, 2355, 2356, 2357, 2480, 2481, 2482, 2483, 2484, 2485,
    2608, 2609, 2610, 2611, 2612, 2613, 2736, 2737, 2738, 2739, 2740, 2741, 2864, 2865, 2866, 2867,
    2868, 2869, 2992, 2993, 2994, 2995, 2996, 2997, 96, 97, 98, 224, 225, 226, 352, 353,
    354, 480, 481, 482, 608, 609, 610, 736, 737, 738, 864, 865, 866, 992, 993, 994,
    88, 89, 90, 216, 217, 218, 344, 345, 346, 472, 473, 474, 600, 601, 602, 728,
    729, 730, 856, 857, 858, 984, 985, 986, 1048, 1049, 1050, 1051, 1176, 1177, 1178, 1179,
    1304, 1305, 1306, 1307, 1432, 1433, 1434, 1435, 1560, 1561, 1562, 1563, 1688, 1689, 1690, 1691,
    1816, 1817, 1818, 1819, 1944, 1945, 1946, 1947, 2088, 2089, 2090, 2091, 2092, 2093, 2216, 2217,
    2218, 2219, 2220, 2221, 2344, 2345, 2346, 2347, 2348, 2349, 2472, 2473, 2474, 2475, 2476, 2477,
    2600, 2601, 2602, 2603, 2604, 2605, 2728, 2729, 2730, 2731, 2732, 2733, 2856, 2857, 2858, 2859,
    2860, 2861, 2984, 2985, 2986, 2987, 2988, 2989, 80, 81, 82, 208, 209, 210, 336, 337,
    338, 464, 465, 466, 592, 593, 594, 720, 721, 722, 848, 849, 850, 976, 977, 978,
    72, 73, 74, 200, 201, 202, 328, 329, 330, 456, 457, 458, 584, 585, 586, 712,
    713, 714, 840, 841, 842, 968, 969, 970, 2080, 2081, 2082, 2083, 2084, 2085, 2208, 2209,
    2210, 2211, 2212, 2213, 2336, 2337, 2338, 2339, 2340, 2341, 2464, 2465, 2466, 2467, 2468, 2469,
    2592, 2593, 2594, 2595, 2596, 2597, 2720, 2721, 2722, 2723, 2724, 2725, 2848, 2849, 2850, 2851,
    2852, 2853, 2976, 2977, 2978, 2979, 2980, 2981, 64, 65, 66, 192, 193, 194, 320, 321,
    322, 448, 449, 450, 576, 577, 578, 704, 705, 706, 832, 833, 834, 960, 961, 962,
    1040, 1041, 1042, 1043, 1168, 1169, 1170, 1171, 1296, 1297, 1298, 1299, 1424, 1425, 1426, 1427,
    1552, 1553, 1554, 1555, 1680, 1681, 1682, 1683, 1808, 1809, 1810, 1811, 1936, 1937, 1938, 1939,
    56, 57, 58, 184, 185, 186, 312, 313, 314, 440, 441, 442, 568, 569, 570, 696,
    697, 698, 824, 825, 826, 952, 953, 954, 2072, 2073, 2074, 2075, 2076, 2077, 2200, 2201,
    2202, 2203, 2204, 2205, 2328, 2329, 2330, 2331, 2332, 2333, 2456, 2457, 2458, 2459, 2460, 2461,
    2584, 2585, 2586, 2587, 2588, 2589, 2712, 2713, 2714, 2715, 2716, 2717, 2840, 2841, 2842, 2843,
    2844, 2845, 2968, 2969, 2970, 2971, 2972, 2973, 48, 49, 50, 176, 177, 178, 304, 305,
    306, 432, 433, 434, 560, 561, 562, 688, 689, 690, 816, 817, 818, 944, 945, 946,
    40, 41, 42, 168, 169, 170, 296, 297, 298, 424, 425, 426, 552, 553, 554, 680,
    681, 682, 808, 809, 810, 936, 937, 938, 1032, 1033, 1034, 1035, 1160, 1161, 1162, 1163,
    1288, 1289, 1290, 1291, 1416, 1417, 1418, 1419, 1544, 1545, 1546, 1547, 1672, 1673, 1674, 1675,
    1800, 1801, 1802, 1803, 1928, 1929, 1930, 1931, 2064, 2065, 2066, 2067, 2068, 2069, 2192, 2193,
    2194, 2195, 2196, 2197, 2320, 2321, 2322, 2323, 2324, 2325, 2448, 2449, 2450, 2451, 2452, 2453,
    2576, 2577, 2578, 2579, 2580, 2581, 2704, 2705, 2706, 2707, 2708, 2709, 2832, 2833, 2834, 2835,
    2836, 2837, 2960, 2961, 2962, 2963, 2964, 2965, 32, 33, 34, 160, 161, 162, 288, 289,
    290, 416, 417, 418, 544, 545, 546, 672, 673, 674, 800, 801, 802, 928, 929, 930,
    24, 25, 26, 152, 153, 154, 280, 281, 282, 408, 409, 410, 536, 537, 538, 664,
    665, 666, 792, 793, 794, 920, 921, 922, 2056, 2057, 2058, 2059, 2060, 2061, 2184, 2185,
    2186, 2187, 2188, 2189, 2312, 2313, 2314, 2315, 2316, 2317, 2440, 2441, 2442, 2443, 2444, 2445,
    2568, 2569, 2570, 2571, 2572, 2573, 2696, 2697, 2698, 2699, 2700, 2701, 2824, 2825, 2826, 2827,
    2828, 2829, 2952, 2953, 2954, 2955, 2956, 2957, 16, 17, 18, 144, 145, 146, 272, 273,
    274, 400, 401, 402, 528, 529, 530, 656, 657, 658, 784, 785, 786, 912, 913, 914,
    1024, 1025, 1026, 1027, 1152, 1153, 1154, 1155, 1280, 1281, 1282, 1283, 1408, 1409, 1410, 1411,
    1536, 1537, 1538, 1539, 1664, 1665, 1666, 1667, 1792, 1793, 1794, 1795, 1920, 1921, 1922, 1923,
    8, 9, 10, 136, 137, 138, 264, 265, 266, 392, 393, 394, 520, 521, 522, 648,
    649, 650, 776, 777, 778, 904, 905, 906, 2048, 2049, 2050, 2051, 2052, 2053, 2176, 2177,
    2178, 2179, 2180, 2181, 2304, 2305, 2306, 2307, 2308, 2309, 2432, 2433, 2434, 2435, 2436, 2437,
    2560, 2561, 2562, 2563, 2564, 2565, 2688, 2689, 2690, 2691, 2692, 2693, 2816, 2817, 2818, 2819,
    2820, 2821, 2944, 2945, 2946, 2947, 2948, 2949, 0, 1, 2, 128, 129, 130, 256, 257,
    258, 384, 385, 386, 512, 513, 514, 640, 641, 642, 768, 769, 770, 896, 897, 898,
};

typedef short bf16x8 __attribute__((ext_vector_type(8)));
typedef short s16x4 __attribute__((ext_vector_type(4)));
typedef float f32x16 __attribute__((ext_vector_type(16)));
constexpr int AT_KST = 144, AT_VST = 192;
constexpr int AT_KBUF = 64 * AT_KST, AT_VBUF = 64 * AT_VST;
constexpr int AT_K0 = 0, AT_V0 = 2 * AT_KBUF;
constexpr int AT_KBUF2 = 128 * AT_KST, AT_VBUF2 = 128 * AT_VST, AT_V02 = 2 * AT_KBUF2, AT_MISC = AT_V02 + 2 * AT_VBUF2;
constexpr float AT_NEG = -1e30f;
constexpr int CW_ATTQ = 8192;

__device__ __forceinline__ s16x4 at_vtr(LAS const unsigned char* p) { return __builtin_bit_cast(s16x4, __builtin_amdgcn_ds_read_tr16_b64_v4i16((LAS s16x4*)p)); }
__device__ __forceinline__ unsigned at_cvt(float lo, float hi) { unsigned r; asm("v_cvt_pk_bf16_f32 %0, %1, %2" : "=v"(r) : "v"(lo), "v"(hi)); return r; }

template <int NSTEP, int Q0>
__device__ __forceinline__ void at_qk(f32x16 (&S)[2], LAS const unsigned char* kl, const bf16x8 (&qf)[4]) {
#pragma unroll
    for (int kb = 0; kb < 2; ++kb) {
        f32x16 acc = {};
#pragma unroll
        for (int s = 0; s < NSTEP; ++s) { const bf16x8 a = *(LAS const bf16x8*)(kl + kb * 32 * AT_KST + s * 32); acc = __builtin_amdgcn_mfma_f32_32x32x16_bf16(a, qf[Q0 + s], acc, 0, 0, 0); }
        S[kb] = acc;
    }
}
__device__ __forceinline__ void at_softmax(f32x16 (&S)[2], float& m, float& l, f32x16 (&O)[2]) {
    (void)m; (void)O;
    float s0 = 0.f, s1 = 0.f;
#pragma unroll
    for (int i = 0; i < 16; ++i) { const float p0 = __builtin_amdgcn_exp2f(S[0][i]), p1 = __builtin_amdgcn_exp2f(S[1][i]); S[0][i] = p0; S[1][i] = p1; s0 += p0; s1 += p1; }
    l += s0 + s1;
}
template <bool LANEMASK = false>
__device__ __forceinline__ void at_pv(f32x16 (&O)[2], const f32x16 (&S)[2], LAS const unsigned char* vl, unsigned pmask = ~0u) {
#pragma unroll
    for (int ks = 0; ks < 4; ++ks) {
        const int kb = ks >> 1, s8 = (ks & 1) * 8;
        u32x4 pw; pw.x = at_cvt(S[kb][s8], S[kb][s8 + 1]); pw.y = at_cvt(S[kb][s8 + 2], S[kb][s8 + 3]); pw.z = at_cvt(S[kb][s8 + 4], S[kb][s8 + 5]); pw.w = at_cvt(S[kb][s8 + 6], S[kb][s8 + 7]);
        if (LANEMASK) { pw.x &= pmask; pw.y &= pmask; pw.z &= pmask; pw.w &= pmask; }
        const bf16x8 pf = __builtin_bit_cast(bf16x8, pw);
#pragma unroll
        for (int db = 0; db < 2; ++db) {
            const s16x4 lo = at_vtr(vl + (ks * 16) * AT_VST + db * 64), hi = at_vtr(vl + (ks * 16 + 8) * AT_VST + db * 64);
            const bf16x8 vf = {lo[0], lo[1], lo[2], lo[3], hi[0], hi[1], hi[2], hi[3]};
            O[db] = __builtin_amdgcn_mfma_f32_32x32x16_bf16(vf, pf, O[db], 0, 0, 0);
        }
    }
}
__device__ __forceinline__ void at_mask_causal(f32x16 (&S)[2], int qrel, int h) {
#pragma unroll
    for (int kb = 0; kb < 2; ++kb)
#pragma unroll
        for (int i = 0; i < 16; ++i) { const int kvt = kb * 32 + (i & 3) + 8 * (i >> 2) + 4 * h; if (kvt > qrel) S[kb][i] = AT_NEG; }
}
__device__ __forceinline__ void at_mask_bits(f32x16 (&S)[2], unsigned long long w, int h) {
    const unsigned long long ws = w >> (4 * h); const unsigned b0 = (unsigned)ws, b1 = (unsigned)(ws >> 32);
#pragma unroll
    for (int i = 0; i < 16; ++i) { const int sh = (i & 3) + 8 * (i >> 2);
        const float p0 = S[0][i], p1 = S[1][i];
        S[0][i] = __builtin_bit_cast(float, __builtin_bit_cast(unsigned, p0) & (unsigned)__builtin_amdgcn_sbfe(b0, sh, 1));
        S[1][i] = __builtin_bit_cast(float, __builtin_bit_cast(unsigned, p1) & (unsigned)__builtin_amdgcn_sbfe(b1, sh, 1)); }
}
__device__ __forceinline__ void at_exp(f32x16 (&S)[2]) {
#pragma unroll
    for (int i = 0; i < 16; ++i) { S[0][i] = __builtin_amdgcn_exp2f(S[0][i]); S[1][i] = __builtin_amdgcn_exp2f(S[1][i]); }
}
__device__ __forceinline__ void at_rowsum(const f32x16 (&S)[2], float& l) {
    float s0 = 0.f, s1 = 0.f;
#pragma unroll
    for (int i = 0; i < 16; ++i) { s0 += S[0][i]; s1 += S[1][i]; }
    l += s0 + s1;
}
__device__ __forceinline__ void at_store(const f32x16 (&O)[2], float rl, bf16* yrow, int h) {
#pragma unroll
    for (int db = 0; db < 2; ++db)
#pragma unroll
        for (int g4 = 0; g4 < 4; ++g4) {
            const unsigned long long w = (unsigned long long)at_cvt(O[db][4 * g4] * rl, O[db][4 * g4 + 1] * rl) | ((unsigned long long)at_cvt(O[db][4 * g4 + 2] * rl, O[db][4 * g4 + 3] * rl) << 32);
            *(unsigned long long*)(yrow + db * 32 + 8 * g4 + 4 * h) = w;
        }
}

__device__ __forceinline__ void at_kload(bf16x8 (&kf)[8], LAS const unsigned char* kl) {
#pragma unroll
    for (int kb = 0; kb < 2; ++kb)
#pragma unroll
        for (int s = 0; s < 4; ++s) kf[kb * 4 + s] = *(LAS const bf16x8*)(kl + kb * 32 * AT_KST + s * 32);
}
__device__ __forceinline__ void at_qk_regs(f32x16 (&S)[2], const bf16x8 (&kf)[8], const bf16x8 (&qf)[4]) {
#pragma unroll
    for (int kb = 0; kb < 2; ++kb) {
        f32x16 acc = {};
#pragma unroll
        for (int s = 0; s < 4; ++s) acc = __builtin_amdgcn_mfma_f32_32x32x16_bf16(kf[kb * 4 + s], qf[s], acc, 0, 0, 0);
        S[kb] = acc;
    }
}
__device__ __forceinline__ void at_qk_half(f32x16& S, LAS const unsigned char* kl, const bf16x8 (&qf)[4]) {
    bf16x8 kf[4];
#pragma unroll
    for (int s = 0; s < 4; ++s) kf[s] = *(LAS const bf16x8*)(kl + s * 32);
    __builtin_amdgcn_sched_barrier(0);
    f32x16 acc = {};
#pragma unroll
    for (int s = 0; s < 4; ++s) acc = __builtin_amdgcn_mfma_f32_32x32x16_bf16(kf[s], qf[s], acc, 0, 0, 0);
    S = acc;
}
__device__ __forceinline__ void at_vload(s16x4 (&vlo)[8], s16x4 (&vhi)[8], LAS const unsigned char* vl) {
#pragma unroll
    for (int ks = 0; ks < 4; ++ks)
#pragma unroll
        for (int db = 0; db < 2; ++db) { vlo[ks * 2 + db] = at_vtr(vl + (ks * 16) * AT_VST + db * 64); vhi[ks * 2 + db] = at_vtr(vl + (ks * 16 + 8) * AT_VST + db * 64); }
}
template <bool LANEMASK = false>
__device__ __forceinline__ void at_pv_regs(f32x16 (&O)[2], const f32x16 (&S)[2], const s16x4 (&vlo)[8], const s16x4 (&vhi)[8], unsigned pmask = ~0u) {
#pragma unroll
    for (int ks = 0; ks < 4; ++ks) {
        const int kb = ks >> 1, s8 = (ks & 1) * 8;
        u32x4 pw; pw.x = at_cvt(S[kb][s8], S[kb][s8 + 1]); pw.y = at_cvt(S[kb][s8 + 2], S[kb][s8 + 3]); pw.z = at_cvt(S[kb][s8 + 4], S[kb][s8 + 5]); pw.w = at_cvt(S[kb][s8 + 6], S[kb][s8 + 7]);
        if (LANEMASK) { pw.x &= pmask; pw.y &= pmask; pw.z &= pmask; pw.w &= pmask; }
        const bf16x8 pf = __builtin_bit_cast(bf16x8, pw);
#pragma unroll
        for (int db = 0; db < 2; ++db) {
            const s16x4 lo = vlo[ks * 2 + db], hi = vhi[ks * 2 + db];
            const bf16x8 vf = {lo[0], lo[1], lo[2], lo[3], hi[0], hi[1], hi[2], hi[3]};
            O[db] = __builtin_amdgcn_mfma_f32_32x32x16_bf16(vf, pf, O[db], 0, 0, 0);
        }
    }
}
struct AtCtx { const bf16* PROJ; const unsigned long long* MASKA; const float* KMEAN; bf16* Y; const float* dsub; float lam, lam_init; };

template <int KIND>
__device__ __forceinline__ void at_unit(const AtCtx& C, int b, int x, int y, LAS unsigned char* lds, int tid, int lane, int wave) {
    const int r = lane & 31, h = lane >> 5;
    int qw, kcol, vcol, NT;
    int qcol0, qcol1 = 0, ycol;
    if (KIND == 0) { const int head = 2 * y + (wave >> 2); qw = 128 * x + 32 * (wave & 3); kcol = C_KA; vcol = C_VA; NT = 2 * (x + 1); qcol0 = C_QA + 64 * head; ycol = 64 * head; }
    else if (KIND == 1) { qw = 256 * x + 32 * wave; kcol = C_KB + 64 * y; vcol = C_VB + 64 * y; NT = 4 * (x + 1); qcol0 = C_QB + 64 * y; qcol1 = qcol0 + 32; ycol = 384 + 64 * y; }
    else { qw = 256 * x + 32 * wave; kcol = C_KC + 64 * y; vcol = C_VC + 64 * y; NT = 4 * (x + 1); qcol0 = C_QC + 64 * y; ycol = 640 + 64 * y; }
    const int q = qw + r;
    const unsigned mrow = (unsigned)(b * SEQ + q);
    const bf16* kvbase = C.PROJ + (size_t)b * SEQ * NP;
    bf16x8 qf[4];
    if (KIND == 1) {
#pragma unroll
        for (int s = 0; s < 2; ++s) { qf[s] = *(const bf16x8*)(C.PROJ + (size_t)mrow * NP + qcol0 + 16 * s + 8 * h); qf[2 + s] = *(const bf16x8*)(C.PROJ + (size_t)mrow * NP + qcol1 + 16 * s + 8 * h); }
    } else {
#pragma unroll
        for (int s = 0; s < 4; ++s) qf[s] = *(const bf16x8*)(C.PROJ + (size_t)mrow * NP + qcol0 + 16 * s + 8 * h);
    }
    unsigned selb = 0u;
    f32x16 O0[2], O1[2];
    float m0 = AT_NEG, l0 = 0.f, m1 = AT_NEG, l1 = 0.f;
#pragma unroll
    for (int d = 0; d < 2; ++d) { O0[d] = (f32x16){}; O1[d] = (f32x16){}; }
    const int srow = tid >> 3, sch = tid & 7;
    const unsigned kofs = (unsigned)(srow * NP + kcol + 8 * sch), vofs = (unsigned)(srow * NP + vcol + 8 * sch);
#define kg (kvbase + kofs)
#define vg (kvbase + vofs)
    LAS unsigned char* kst = lds + AT_K0 + srow * AT_KST + sch * 16;
    LAS unsigned char* vst = lds + AT_V0 + srow * AT_VST + sch * 16;
    LAS const unsigned char* kl = lds + AT_K0 + r * AT_KST + h * 16;
    LAS const unsigned char* vl = lds + AT_V0 + (4 * h + ((lane & 15) >> 2)) * AT_VST + (16 * ((lane >> 4) & 1) + 4 * (lane & 3)) * 2;
    if (KIND == 1) {
        u32x4 kr0, vr0;
        kr0 = *(const u32x4*)kg; vr0 = *(const u32x4*)vg;
        *(LAS u32x4*)kst = kr0; *(LAS u32x4*)vst = vr0;
        __syncthreads();
#define AT_DSTEP(KL, VL, KW, VW, tt) do { const int t = (tt), cur = t & 1, kv0 = 64 * t; \
            if (t + 1 < NT) { KL = *(const u32x4*)(kg + (size_t)(kv0 + 64) * NP); VL = *(const u32x4*)(vg + (size_t)(kv0 + 64) * NP); } \
            if (kv0 <= qw + 31) { \
                LAS const unsigned char* klc = kl + cur * AT_KBUF; \
                LAS const unsigned char* vlc = vl + cur * AT_VBUF; \
                f32x16 S[2]; \
                at_qk<2, 0>(S, klc, qf); \
                if (kv0 + 63 > qw) at_mask_causal(S, q - kv0, h); \
                at_softmax(S, m0, l0, O0); \
                at_pv(O0, S, vlc); \
                at_qk<2, 2>(S, klc + 64, qf); \
                if (kv0 + 63 > qw) at_mask_causal(S, q - kv0, h); \
                at_softmax(S, m1, l1, O1); \
                at_pv(O1, S, vlc); \
            } \
            if (t + 1 < NT) { *(LAS u32x4*)(kst + (cur ^ 1) * AT_KBUF) = KW; *(LAS u32x4*)(vst + (cur ^ 1) * AT_VBUF) = VW; } \
            __syncthreads(); } while (0)
        for (int t2 = 0; t2 < NT; ++t2) { AT_DSTEP(kr0, vr0, kr0, vr0, t2); }
#undef AT_DSTEP
    } else {
        LAS unsigned char* kst2 = lds + AT_K0 + srow * AT_KST + sch * 16;
        LAS unsigned char* vst2 = lds + AT_V02 + srow * AT_VST + sch * 16;
        LAS const unsigned char* vl2 = lds + AT_V02 + (4 * h + ((lane & 15) >> 2)) * AT_VST + (16 * ((lane >> 4) & 1) + 4 * (lane & 3)) * 2;
        const int NS = NT >> 1;
        u32x4 ka = *(const u32x4*)kg, kb = *(const u32x4*)(kg + (size_t)64 * NP), va = *(const u32x4*)vg, vb = *(const u32x4*)(vg + (size_t)64 * NP);
        *(LAS u32x4*)kst2 = ka; *(LAS u32x4*)(kst2 + 64 * AT_KST) = kb; *(LAS u32x4*)vst2 = va; *(LAS u32x4*)(vst2 + 64 * AT_VST) = vb;
        unsigned long long mw0 = 0ull, mw1 = 0ull, mn0 = 0ull, mn1 = 0ull;
        if (KIND == 0) { mw0 = C.MASKA[(size_t)mrow * 32]; if (64 <= qw + 31) mw1 = C.MASKA[(size_t)mrow * 32 + 1]; }
        LAS float* kmL = (LAS float*)(lds + AT_MISC + 256);
        if (KIND == 2) kmL[tid] = C.KMEAN[(size_t)(b * 6 + y) * 512 + tid];
        __syncthreads();
        if (KIND == 2) {
            const int npast = x;
            float gt[8];
#pragma unroll
            for (int n = 0; n < 8; ++n) {
                float a = 0.f;
#pragma unroll
                for (int s = 0; s < 4; ++s) {
                    const f32x4 k0 = *(const LAS f32x4*)(kmL + n * 64 + 16 * s + 8 * h), k1 = *(const LAS f32x4*)(kmL + n * 64 + 16 * s + 8 * h + 4);
                    const u32x4 qw4 = __builtin_bit_cast(u32x4, qf[s]);
                    a += bflo(qw4.x) * k0.x + bfhi(qw4.x) * k0.y + bflo(qw4.y) * k0.z + bfhi(qw4.y) * k0.w + bflo(qw4.z) * k1.x + bfhi(qw4.z) * k1.y + bflo(qw4.w) * k1.z + bfhi(qw4.w) * k1.w;
                }
                a += __shfl_xor(a, 32);
                asm volatile("" : "+v"(a) :: "memory");
                gt[n] = a;
            }
#pragma unroll
            for (int n = 0; n < 8; ++n) { int rank = 0;
#pragma unroll
                for (int j = 0; j < 8; ++j) rank += (j < npast && (gt[j] > gt[n] || (gt[j] == gt[n] && j < n))) ? 1 : 0;
                if (n < npast && rank < 3) selb |= 1u << n; }
        }
        for (int st = 0; st < NS; ++st) {
            const int cur = st & 1;
            if (st + 1 < NS) { const size_t go = (size_t)(128 * (st + 1)) * NP;
                ka = *(const u32x4*)(kg + go); kb = *(const u32x4*)(kg + go + (size_t)64 * NP); va = *(const u32x4*)(vg + go); vb = *(const u32x4*)(vg + go + (size_t)64 * NP);
                if (KIND == 0) { mn0 = 0ull; mn1 = 0ull; if (128 * (st + 1) <= qw + 31) mn0 = C.MASKA[(size_t)mrow * 32 + 2 * st + 2]; if (128 * (st + 1) + 64 <= qw + 31) mn1 = C.MASKA[(size_t)mrow * 32 + 2 * st + 3]; } }
#pragma unroll
            for (int sub = 0; sub < 2; ++sub) {
                const int t_ = 2 * st + sub, kv0 = 64 * t_;
                bool rel = kv0 <= qw + 31, lsel = true;
                if (KIND == 2) { const int n_ = t_ >> 2; if (n_ < x) { lsel = (selb >> n_) & 1u; rel = rel && __any(lsel); } }
                if (rel) {
                    LAS const unsigned char* klc = kl + cur * AT_KBUF2 + sub * 64 * AT_KST;
                    LAS const unsigned char* vlc = vl2 + cur * AT_VBUF2 + sub * 64 * AT_VST;
                    f32x16 S[2];
                    at_qk_half(S[0], klc, qf); at_qk_half(S[1], klc + 32 * AT_KST, qf);
                    if (KIND == 2) { if ((t_ >> 2) >= x && kv0 + 63 > qw) at_mask_causal(S, q - kv0, h); }
                    at_exp(S);
                    if (KIND == 0) at_mask_bits(S, sub ? mw1 : mw0, h);
                    if (KIND == 2 && (t_ >> 2) < x) { float sm_ = 0.f; at_rowsum(S, sm_); l0 += lsel ? sm_ : 0.f; at_pv<true>(O0, S, vlc, lsel ? ~0u : 0u); }
                    else { at_rowsum(S, l0); at_pv(O0, S, vlc); }
                }
            }
            if (st + 1 < NS) { LAS unsigned char* kd = kst2 + (cur ^ 1) * AT_KBUF2; LAS unsigned char* vd = vst2 + (cur ^ 1) * AT_VBUF2;
                *(LAS u32x4*)kd = ka; *(LAS u32x4*)(kd + 64 * AT_KST) = kb; *(LAS u32x4*)vd = va; *(LAS u32x4*)(vd + 64 * AT_VST) = vb; }
            __syncthreads();
            mw0 = mn0; mw1 = mn1;
        }
    }
#undef kg
#undef vg
    l0 += __shfl_xor(l0, 32);
    bf16* yrow = C.Y + (size_t)mrow * DM + ycol;
    if (KIND == 1) {
        l1 += __shfl_xor(l1, 32);
        const float r0 = 1.f / l0, r1 = C.lam / l1;
        float ss = 0.f;
#pragma unroll
        for (int d = 0; d < 2; ++d)
#pragma unroll
            for (int i = 0; i < 16; ++i) { const float o = O0[d][i] * r0 - O1[d][i] * r1; O0[d][i] = o; ss += o * o; }
        ss += __shfl_xor(ss, 32);
        const float rs = (1.f / sqrtf(ss * (1.f / 64.f) + 1e-5f)) * (1.f - C.lam_init);
#pragma unroll
        for (int d = 0; d < 2; ++d)
#pragma unroll
            for (int g4 = 0; g4 < 4; ++g4) { const f32x4 gs = *(const f32x4*)(C.dsub + d * 32 + 8 * g4 + 4 * h);
                O0[d][4 * g4] *= gs.x; O0[d][4 * g4 + 1] *= gs.y; O0[d][4 * g4 + 2] *= gs.z; O0[d][4 * g4 + 3] *= gs.w; }
        at_store(O0, rs, yrow, h);
    } else {
        at_store(O0, 1.f / l0, yrow, h);
    }
}
__device__ __forceinline__ void phase_attn_mfma(const AtCtx& C, unsigned* qhead, LAS unsigned char* lds, int tid, int lane, int wave) {
    LAS int* uq = (LAS int*)(lds + AT_MISC);
    for (;;) {
        if (tid == 0) uq[0] = (int)__hip_atomic_fetch_add(qhead, 1u, __ATOMIC_RELAXED, __HIP_MEMORY_SCOPE_AGENT);
        __syncthreads();
        const int ui = __builtin_amdgcn_readfirstlane(uq[0]);
        __syncthreads();
        if (ui >= 1024 * (1 + PROBE_ATT2)) break;
        const unsigned e = ATT_UNITS[ui & 1023];
        const int kind = e >> 10, b = (e >> 7) & 7, x = (e >> 3) & 15, y = e & 7;
        int tid_u = tid; asm volatile("" : "+v"(tid_u));
        const int lane_u = tid_u & 63;
        if (kind == 0) at_unit<0>(C, b, x, y, lds, tid_u, lane_u, wave);
        else if (kind == 1) at_unit<1>(C, b, x, y, lds, tid_u, lane_u, wave);
        else at_unit<2>(C, b, x, y, lds, tid_u, lane_u, wave);
    }
}

__device__ __forceinline__ ArgsP get_args() { ArgsP p = (ArgsP)__builtin_amdgcn_kernarg_segment_ptr(); asm volatile("" : "+s"(p)); return p; }
#define SITE_VARS ArgsP AP = get_args(); unsigned char* ws = AP->ws; int G = gridDim.x, wg = blockIdx.x; asm volatile("" : "+s"(G), "+s"(wg)); int tid = threadIdx.x; asm volatile("" : "+v"(tid)); \
    const int lane = tid & 63, wave = __builtin_amdgcn_readfirstlane(tid >> 6), gw = wg * NWAVES + wave, ngw = G * NWAVES; (void)gw; (void)ngw; (void)ws; (void)lane;

__global__ void __launch_bounds__(NTHR, 2) mega_fwd(Args Aarg) {
    extern __shared__ __attribute__((aligned(16))) unsigned char lds_raw[];
    LAS unsigned char* lds = (LAS unsigned char*)lds_raw;
    volatile LAS unsigned* MISC = (volatile LAS unsigned*)(lds + MISC_OFF);
    if (threadIdx.x < 32) MISC[threadIdx.x] = 0u;
    __syncthreads();
    const int lo = Aarg.ph_lo, hi = Aarg.ph_hi;
    XcdBarrier bar; bar.bar = (unsigned*)(Aarg.ws + WS_CTL) + CW_BAR; bar.x = 0; bar.st = nullptr;
    if (hi - lo > 1) bar = xcd_barrier_post((unsigned*)(Aarg.ws + WS_CTL) + CW_BAR, MISC + 8);
    int ph = 0;
    const bool g256 = gridDim.x == 256;
#define PH_BEGIN if (ph >= lo && ph < hi) { SITE_VARS
#define PH_END   if (ph + 1 < hi) { xcd_barrier(bar); if (PROBE_BAR) xcd_barrier(bar); } } ++ph;
#define WSP(type, off) ((type)(ws + (off)))
#define RFL(x) __builtin_amdgcn_readfirstlane(x)

    PH_BEGIN { for (int rep = 0; rep < 1 + PROBE_P0; ++rep) { p0_prologue(AP, lds, wg, G, tid); __syncthreads(); } } PH_END

    for (int l = 0; l < DEPTH; ++l) {
        const float lam_init = 0.8f - 0.6f * expf(-0.3f * (float)l);
        const int j = l >> 1;
        if (!(g256 && (l & 1))) {
        PH_BEGIN { const float* mod_l = WSP(const float*, WS_MOD) + (size_t)l * NB * MODW;
            if (l == 2) {
                LAS int* tb = (LAS int*)(lds + MOE_TB_OFF); LAS int* cn = (LAS int*)(lds + MOE_CN_OFF);
                moe_tables(WSP(const unsigned*, WS_CTL) + CW_MOECNT, tb, cn, tid);
                phase_norm<true, false>(WSP(const void*, WS_X), WSP(bf16*, WS_X), AP->g_attn + (size_t)l * DM, mod_l, 0, DM, WSP(bf16*, WS_H), nullptr,
                                        WSP(const bf16*, WS_R), WSP(const int*, WS_ENTI), WSP(const float*, WS_ENTW), mod_l - (size_t)NB * MODW + 5 * DM, tb, gw, ngw, lane);
            } else {
                if (l == 0) phase_norm<false, false, false, false>(AP->x, nullptr, AP->g_attn + (size_t)l * DM, mod_l, 0, DM, WSP(bf16*, WS_H), nullptr, nullptr, nullptr, nullptr, nullptr, nullptr, gw, ngw, lane);
                else for (int rep = 0; rep < 1 + PROBE_NORM; ++rep) phase_norm<false, false>(WSP(const void*, WS_X), nullptr, AP->g_attn + (size_t)l * DM, mod_l, 0, DM, WSP(bf16*, WS_H), nullptr, nullptr, nullptr, nullptr, nullptr, nullptr, gw, ngw, lane);
            } } PH_END
        }
        PH_BEGIN {
            pg8::Gemm g{WSP(const bf16*, WS_H), WSP(const bf16*, WS_WIN + l * SZ_WIN), T, NP, DM}; pg8::StaticOrder S; S.init(T, NP, G, wg);
            pg8::EpiProj E{WSP(bf16*, WS_PROJ), WSP(float*, WS_WI), WSP(const float*, WS_ROPE), nullptr, nullptr};
            for (int rep = 0; rep < 1 + PROBE_PROJ; ++rep) { pg8::gemm_phase<pg8::EpiProj, pg8::StaticOrder, true, true>(lds, g, S, E, tid); __syncthreads(); }
        } PH_END
        PH_BEGIN {
            for (int rep = 0; rep < 1 + PROBE_IDX; ++rep)
            for (int it = wg; it < 1024 + 384; it += G) {
                if (it < 1024) { const int k = it / G, c = it % G; int u16 = it;
                    if (G == 256) { const int ti = c & 127; u16 = (2 * k + (c >> 7)) * 128 + ((k & 1) ? 127 - ti : ti); }
                    idx_unit16(u16, WSP(const bf16*, WS_PROJ), WSP(const float*, WS_WI), WSP(unsigned long long*, WS_MASKA), lds, tid, lane, wave); }
                else for (int rk = 0; rk < 1 + PROBE_KM; ++rk) kmean_unit(it - 1024, WSP(const bf16*, WS_PROJ), WSP(float*, WS_KMEAN), lds, tid);
            }
        } PH_END
        PH_BEGIN {
            const float* dl = AP->dlam + (size_t)l * 128;
            float sa = 0.f, sb = 0.f;
            if (lane < 32) { sa = dl[lane] * dl[32 + lane]; sb = dl[64 + lane] * dl[96 + lane]; }
            const float lam = expf(wave_sum(sa)) - expf(wave_sum(sb)) + lam_init;
            AtCtx C{WSP(const bf16*, WS_PROJ), WSP(const unsigned long long*, WS_MASKA), WSP(const float*, WS_KMEAN), WSP(bf16*, WS_Y), AP->dsub + (size_t)l * 64, lam, lam_init};
            if ((l & 1) && wg < NB) {
                const float* mod_l = WSP(const float*, WS_MOD) + (size_t)l * NB * MODW; const float* wrt = WSP(const float*, WS_WRT) + (size_t)j * NE * DM;
                LAS float* red = (LAS float*)lds;
                const float s0 = mod_l[(size_t)wg * MODW + 3 * DM + tid], s1 = mod_l[(size_t)wg * MODW + 3 * DM + tid + 512];
#pragma unroll
                for (int e = 0; e < 8; ++e) { const float v = wave_sum(s0 * wrt[e * DM + tid] + s1 * wrt[e * DM + tid + 512]); if (lane == 0) red[wave * 8 + e] = v; }
                __syncthreads();
                if (tid < 8) { float t = 0.f;
#pragma unroll
                    for (int w = 0; w < 8; ++w) t += red[w * 8 + tid];
                    WSP(float*, WS_RB8)[wg * 8 + tid] = t; }
                __syncthreads();
            }
            for (int rep = 0; rep < 1 + PROBE_ATT; ++rep) phase_attn_mfma(C, WSP(unsigned*, WS_CTL) + CW_ATTQ + 64 * l + 16 * rep, lds, tid, lane, wave);
        } PH_END
        PH_BEGIN { const float* mod_l = WSP(const float*, WS_MOD) + (size_t)l * NB * MODW;
            pg8::Gemm g{WSP(const bf16*, WS_Y), WSP(const bf16*, WS_WOUT + l * SZ_WOUT), T, DM, DM}; pg8::StaticOrder S; S.init(T, DM, G, wg);
            if (g256 && (l & 1) == 0) {
                unsigned* pc = WSP(unsigned*, WS_CTL) + CW_PANEL + 512 * l;
                if (l == 0) { pg8::EpiResidNorm<true, true> E{AP->x, WSP(bf16*, WS_X), mod_l + 2 * DM, AP->g_ffn + (size_t)l * DM, mod_l, 3 * DM, 4 * DM, WSP(void*, WS_H), WSP(float*, WS_SSP2), pc, F8_HSCALE, 1.f};
                    pg8::gemm_phase<pg8::EpiResidNorm<true, true>, pg8::StaticOrder, false, true>(lds, g, S, E, tid); }
                else { pg8::EpiResidNorm<false, true> E{WSP(const void*, WS_X), WSP(bf16*, WS_X), mod_l + 2 * DM, AP->g_ffn + (size_t)l * DM, mod_l, 3 * DM, 4 * DM, WSP(void*, WS_H), WSP(float*, WS_SSP2), pc, F8_HSCALE, 1.f};
                    pg8::gemm_phase<pg8::EpiResidNorm<false, true>, pg8::StaticOrder, false, true>(lds, g, S, E, tid); }
            }
            else if (g256) {
                pg8::EpiResidNormRoute E{WSP(const void*, WS_X), WSP(bf16*, WS_X), mod_l + 2 * DM, AP->g_ffn + (size_t)l * DM, mod_l, 3 * DM, 4 * DM, WSP(void*, WS_H), WSP(float*, WS_SSP2),
                                         WSP(unsigned*, WS_CTL) + CW_PANEL2 + 512 * j, F8_HSCALE, WSP(const float*, WS_WRT) + (size_t)j * NE * DM,
                                         WSP(int*, WS_LIST), WSP(int*, WS_ENTI), WSP(float*, WS_ENTW), WSP(unsigned*, WS_CTL) + CW_MOECNT + 64 * j, WSP(const float*, WS_RB8)};
                pg8::gemm_phase<pg8::EpiResidNormRoute, pg8::StaticOrder, false, true>(lds, g, S, E, tid);
            }
            else if (l == 0) { pg8::EpiResid<0, true> E{AP->x, WSP(bf16*, WS_X), mod_l + 2 * DM, nullptr, nullptr, nullptr, nullptr, 1.f};
                pg8::gemm_phase<pg8::EpiResid<0, true>, pg8::StaticOrder, true, true>(lds, g, S, E, tid); }
            else { pg8::EpiResid<0> E{WSP(const void*, WS_X), WSP(bf16*, WS_X), mod_l + 2 * DM, nullptr, nullptr, nullptr, nullptr, 1.f};
                pg8::gemm_phase<pg8::EpiResid<0>, pg8::StaticOrder, true, true>(lds, g, S, E, tid); }
        } PH_END
        if ((l & 1) == 0) {
            if (!g256) {
            PH_BEGIN { const float* mod_l = WSP(const float*, WS_MOD) + (size_t)l * NB * MODW;
                for (int rep = 0; rep < 1 + PROBE_NORM; ++rep) phase_norm<false, false, true>(WSP(const void*, WS_X), nullptr, AP->g_ffn + (size_t)l * DM, mod_l, 3 * DM, 4 * DM, WSP(bf16*, WS_H), nullptr, nullptr, nullptr, nullptr, nullptr, nullptr, gw, ngw, lane); } PH_END
            }
            PH_BEGIN {
                pg8::Gemm g{WSP(const bf16*, WS_H), WSP(const bf16*, WS_WGU + j * SZ_WGU8), T, 2 * DFF, DM / 2}; pg8::StaticOrder S; S.init(T, 2 * DFF, G, wg);
                pg8::EpiSwiGLU E{WSP(bf16*, WS_ACT), 0, 1.f / (F8_WSCALE * F8_HSCALE), nullptr, nullptr, F8_ASCALE};
                for (int rep = 0; rep < 1 + PROBE_DUP; ++rep) { pg8::gemm_phase<pg8::EpiSwiGLU, pg8::StaticOrder, true, true, true>(lds, g, S, E, tid); __syncthreads(); }
            } PH_END
            PH_BEGIN { const float* mod_l = WSP(const float*, WS_MOD) + (size_t)l * NB * MODW;
                pg8::Gemm g{WSP(const bf16*, WS_ACT), WSP(const bf16*, WS_WDN + j * SZ_WDN8), T, DM, DFF / 2}; pg8::StaticOrder S; S.init(T, DM, G, wg);
                if (g256) {
                    pg8::EpiResidNorm<false, false> E{WSP(const void*, WS_X), WSP(bf16*, WS_X), mod_l + 5 * DM, AP->g_attn + (size_t)(l + 1) * DM, mod_l + (size_t)NB * MODW, 0, DM, WSP(void*, WS_H), WSP(float*, WS_SSP2),
                                                      WSP(unsigned*, WS_CTL) + CW_PANEL + 512 * (l + 1), 1.f, 1.f / (F8_WSCALE * F8_ASCALE)};
                    pg8::gemm_phase<pg8::EpiResidNorm<false, false>, pg8::StaticOrder, false, true, true>(lds, g, S, E, tid);
                } else {
                pg8::EpiResid<0> E{WSP(const void*, WS_X), WSP(bf16*, WS_X), mod_l + 5 * DM, nullptr, nullptr, nullptr, nullptr, 1.f / (F8_WSCALE * F8_ASCALE)};
                pg8::gemm_phase<pg8::EpiResid<0>, pg8::StaticOrder, true, true, true>(lds, g, S, E, tid); }
            } PH_END
        } else {
            if (!g256) {
            PH_BEGIN { const float* mod_l = WSP(const float*, WS_MOD) + (size_t)l * NB * MODW;
                if (PROBE_ROUTE) phase_norm_route(WSP(const bf16*, WS_X), AP->g_ffn + (size_t)l * DM, mod_l, 3 * DM, 4 * DM, WSP(bf16*, WS_H), AP->w_router + (size_t)j * DM * NE,
                                 WSP(int*, WS_SSP1), WSP(int*, WS_SSP1 + 1024 * 1024), WSP(float*, WS_SSP1 + 2048 * 1024), WSP(unsigned*, WS_CTL) + CW_MOECNT + 64 * j + 32, lds, wg, G, tid, lane, wave);
                phase_norm_route(WSP(const bf16*, WS_X), AP->g_ffn + (size_t)l * DM, mod_l, 3 * DM, 4 * DM, WSP(bf16*, WS_H), AP->w_router + (size_t)j * DM * NE,
                                 WSP(int*, WS_LIST), WSP(int*, WS_ENTI), WSP(float*, WS_ENTW), WSP(unsigned*, WS_CTL) + CW_MOECNT + 64 * j, lds, wg, G, tid, lane, wave); } PH_END
            }
            PH_BEGIN {
                LAS int* tb = (LAS int*)(lds + MOE_TB_OFF); LAS int* cn = (LAS int*)(lds + MOE_CN_OFF);
                const int ntile = moe_tables(WSP(const unsigned*, WS_CTL) + CW_MOECNT + 64 * j, tb, cn, tid);
                for (int rep = 0; rep < 1 + PROBE_GATH; ++rep) phase_moe_gather(WSP(const bf16*, WS_H), WSP(bf16*, WS_HG), WSP(const int*, WS_LIST), tb, cn, ntile, gw, ngw, lane);
            } PH_END
            PH_BEGIN {
                LAS int* tb = (LAS int*)(lds + MOE_TB_OFF); LAS int* cn = (LAS int*)(lds + MOE_CN_OFF);
                const int ntile = moe_tables(WSP(const unsigned*, WS_CTL) + CW_MOECNT + 64 * j, tb, cn, tid);
                pg8::MoeOrder S{22, ntile, G, wg, RFL(tb[1]), RFL(tb[2]), RFL(tb[3]), RFL(tb[4]), RFL(tb[5]), RFL(tb[6]), RFL(tb[7])};
                pg8::Gemm g{WSP(const bf16*, WS_HG), WSP(const bf16*, WS_EGU + (size_t)(j * NE) * SZ_WGU8), ntile * 256, 2 * DFF, DM / 2};
                pg8::EpiSwiGLU E{WSP(bf16*, WS_ACTM), 22, 1.f / (F8_WSCALE * F8_HSCALE), nullptr, nullptr, F8_ASCALE};
                if (PROBE_MUPL) { pg8::MoeOrder S0{22, ntile, G, wg, 1 << 20, 1 << 20, 1 << 20, 1 << 20, 1 << 20, 1 << 20, 1 << 20};
                    pg8::gemm_phase<pg8::EpiSwiGLU, pg8::MoeOrder, true, true, true>(lds, g, S0, E, tid); __syncthreads(); }
                for (int rep = 0; rep < 1 + PROBE_MUP; ++rep) { pg8::gemm_phase<pg8::EpiSwiGLU, pg8::MoeOrder, true, true, true>(lds, g, S, E, tid); __syncthreads(); }
            } PH_END
            PH_BEGIN {
                LAS int* tb = (LAS int*)(lds + MOE_TB_OFF); LAS int* cn = (LAS int*)(lds + MOE_CN_OFF);
                const int ntile = moe_tables(WSP(const unsigned*, WS_CTL) + CW_MOECNT + 64 * j, tb, cn, tid);
                pg8::MoeOrder S{4, ntile, G, wg, RFL(tb[1]), RFL(tb[2]), RFL(tb[3]), RFL(tb[4]), RFL(tb[5]), RFL(tb[6]), RFL(tb[7])};
                pg8::Gemm g{WSP(const bf16*, WS_ACTM), WSP(const bf16*, WS_EDN + (size_t)(j * NE) * SZ_WDN8), ntile * 256, DM, DFF / 2};
                pg8::EpiStoreBf16 E{WSP(bf16*, WS_R), DM, 4, 1.f / (F8_WSCALE * F8_ASCALE)};
                for (int rep = 0; rep < 1 + PROBE_MDN; ++rep) { pg8::gemm_phase<pg8::EpiStoreBf16, pg8::MoeOrder, true, true, true>(lds, g, S, E, tid); __syncthreads(); }
            } PH_END
        }
    }
    PH_BEGIN {
        LAS int* tb = (LAS int*)(lds + MOE_TB_OFF); LAS int* cn = (LAS int*)(lds + MOE_CN_OFF);
        moe_tables(WSP(const unsigned*, WS_CTL) + CW_MOECNT + 64, tb, cn, tid);
        const float* mod3 = WSP(const float*, WS_MOD) + (size_t)3 * NB * MODW;
        for (int rep = 0; rep < 1 + PROBE_FIN; ++rep) phase_norm<true, true>(WSP(const void*, WS_X), nullptr, AP->g_final, nullptr, 0, 0, nullptr, AP->out,
                               WSP(const bf16*, WS_R), WSP(const int*, WS_ENTI), WSP(const float*, WS_ENTW), mod3 + 5 * DM, tb, gw, ngw, lane);
    } PH_END
#undef PH_BEGIN
#undef PH_END
}
constexpr int N_PHASES = 1 + DEPTH * 5 + 2 * 3 + 2 * 4 + 1;

#ifndef MK_MULTI
#define MK_MULTI 0
#endif
extern "C" void kernel_launch(void* const* d_in, const int* in_sizes, int n_in, void* d_out, int out_size, void* d_ws, size_t ws_size, hipStream_t stream) {
    static int grid = 0;
    if (grid == 0) {
        if (n_in != 19 || out_size != T * DM || ws_size < WS_END) { fprintf(stderr, "kernel_launch: unexpected problem (n_in %d, out %d, ws %zu)\n", n_in, out_size, ws_size); grid = -1; return; }
        int dev = 0, cus = 0;
        if (hipGetDevice(&dev) != hipSuccess || hipDeviceGetAttribute(&cus, hipDeviceAttributeMultiprocessorCount, dev) != hipSuccess) { grid = -1; return; }
        if (hipFuncSetAttribute((const void*)mega_fwd, hipFuncAttributeMaxDynamicSharedMemorySize, LDS_BYTES) != hipSuccess) { fprintf(stderr, "kernel_launch: hipFuncSetAttribute failed\n"); grid = -1; return; }
        int per_cu = 0;
        if (hipOccupancyMaxActiveBlocksPerMultiprocessor(&per_cu, (const void*)mega_fwd, NTHR, LDS_BYTES) != hipSuccess || per_cu < 1) fprintf(stderr, "kernel_launch: occupancy query reports %d\n", per_cu);
        (void)hipGetLastError();
        grid = cus;
    }
    if (grid < 0) return;
    (void)hipMemsetAsync((char*)d_ws + WS_CTL, 0, CTL_ZERO_BYTES, stream);
    Args a{};
    a.x = (const float*)d_in[0]; a.c = (const float*)d_in[1]; a.pos = (const int*)d_in[2]; a.w_in = (const float*)d_in[3]; a.w_out = (const float*)d_in[4];
    a.dlam = (const float*)d_in[5]; a.dsub = (const float*)d_in[6]; a.w_ada = (const float*)d_in[7]; a.b_ada = (const float*)d_in[8]; a.g_attn = (const float*)d_in[9]; a.g_ffn = (const float*)d_in[10];
    a.wg = (const float*)d_in[11]; a.wu = (const float*)d_in[12]; a.wd = (const float*)d_in[13]; a.w_router = (const float*)d_in[14]; a.eg = (const float*)d_in[15]; a.eu = (const float*)d_in[16]; a.ed = (const float*)d_in[17];
    a.g_final = (const float*)d_in[18]; a.out = (float*)d_out; a.ws = (unsigned char*)d_ws;
    const int nph = grid == 256 ? N_PHASES - 6 : N_PHASES;
#if MK_MULTI
    for (int p = 0; p < nph; ++p) { a.ph_lo = p; a.ph_hi = p + 1; hipLaunchKernelGGL(mega_fwd, dim3(grid), dim3(NTHR), LDS_BYTES, stream, a); }
#else
    a.ph_lo = 0; a.ph_hi = nph;
    hipLaunchKernelGGL(mega_fwd, dim3(grid), dim3(NTHR), LDS_BYTES, stream, a);
#endif
}
```

```cpp
#include <hip/hip_runtime.h>
#include <cstdio>
#include <cstdint>
#include <cmath>
namespace pg8 {
#define PG8_LAS __attribute__((address_space(3)))
typedef unsigned short bf16_t;
typedef short bf16x8 __attribute__((ext_vector_type(8)));
typedef float f32x4 __attribute__((ext_vector_type(4)));
typedef unsigned u32x4 __attribute__((ext_vector_type(4)));
constexpr int BM = 256, BK = 64, HALF = 128, HTB = HALF * BK * 2  , STAGE_BYTES = 8 * HTB, NXCD = 8, WGM = 8;

__host__ __device__ __forceinline__ int lds_byte(int r, int c) { const int st = (r >> 4) * 2 + (c >> 5), rr = r & 15, cc = c & 31, ob = rr * 64 + cc * 2; return st * 1024 + (ob ^ (((ob >> 9) & 1) << 5)); }
__host__ __device__ __forceinline__ void stage_rc(int b, int& R, int& C) { const int st = b / 1024, sb = b % 1024, swz = sb ^ (((sb >> 9) & 1) << 5); R = (st >> 1) * 16 + swz / 64; C = (st & 1) * 32 + (swz % 64) / 2; }
__host__ __device__ __forceinline__ int perm32(int rho) { const int n = rho >> 4, i = rho & 15; return 8 * (i >> 2) + 4 * n + (i & 3); }

struct Unit { int pm, pn; };
struct Gemm { const bf16_t* A; const bf16_t* Bt; int M, N, K; };

struct StaticOrder {
    int nM, nN, nwg, G, c;
    __host__ __device__ void init(int M, int N, int G_, int c_) { nM = M / BM; nN = N / BM; nwg = nM * nN; G = G_; c = c_; }
    __host__ __device__ bool next(int i, Unit& u) const {
        const long L = (long)i * G + c; if (L >= nwg) return false;
        int wgid = (int)L; { const int q = nwg / NXCD, r = nwg % NXCD, xcd = wgid % NXCD, off = wgid / NXCD; wgid = (xcd < r ? xcd * (q + 1) : r * (q + 1) + (xcd - r) * q) + off; }
        const int nig = WGM * nN, gid = wgid / nig, fm = gid * WGM, gsz = (nM - fm) < WGM ? (nM - fm) : WGM;
        u.pm = fm + ((wgid % nig) % gsz); u.pn = (wgid % nig) / gsz; return true;
    }
    __device__ __forceinline__ void a_ready(const Unit&) const {}
    __device__ __forceinline__ void done(const Unit&) const {}
};

__device__ __forceinline__ unsigned cvt_pk_bf16(float lo, float hi) { unsigned r; asm volatile("v_cvt_pk_bf16_f32 %0, %1, %2" : "=v"(r) : "v"(lo), "v"(hi)); return r; }
typedef float f32x2 __attribute__((ext_vector_type(2)));
typedef int v8i32 __attribute__((ext_vector_type(8)));
typedef int v4i32 __attribute__((ext_vector_type(4)));
__device__ __forceinline__ v8i32 cat8(bf16x8 a, bf16x8 b) { const v4i32 x = __builtin_bit_cast(v4i32, a), y = __builtin_bit_cast(v4i32, b); return (v8i32){x[0], x[1], x[2], x[3], y[0], y[1], y[2], y[3]}; }
template <class Epi, class Sched, bool ALIGN_EPI = false, bool SP2 = false, bool F8 = false>
__device__ __forceinline__ void gemm_phase(PG8_LAS unsigned char* lds, const Gemm g, const Sched& S, const Epi& E, int tid_in) {
    int tid_l = tid_in; asm volatile("" : "+v"(tid_l));
    const int tid = tid_l, wid = __builtin_amdgcn_readfirstlane(tid >> 6), lane = tid & 63, wr = wid >> 2, wc = wid & 3, fr = lane & 15, fq = lane >> 4;
    const int K = g.K, nt = K / BK;
    unsigned voffA[2], voffB[2];
#pragma unroll
    for (int i = 0; i < 2; ++i) { int R, C; stage_rc(tid * 16 + i * 8192, R, C); const int Rb = Epi::PERM ? ((R & ~31) + perm32(R & 31)) : R;
        voffA[i] = (unsigned)(R * K + C) * 2u; voffB[i] = (unsigned)(Rb * K + C) * 2u; }
    const size_t kstep = (size_t)(BK * 2);
    const size_t hstep = (size_t)HALF * K * 2;
    const size_t tstep = 2 * hstep;
    const unsigned ldsw = (unsigned)wid * 1024u;
    const int aoff = lds_byte(wr * 64 + fr, fq * 8), boff = lds_byte(wc * 32 + fr, fq * 8);
#define PG8_SA(b, h) (((b) * 2 + (h)) * HTB)
#define PG8_SB(b, h) ((4 + (b) * 2 + (h)) * HTB)
#define PG8_STAGE(bufoff, gbase, voff) do { _Pragma("unroll") for (int _i = 0; _i < 2; ++_i) \
        __builtin_amdgcn_global_load_lds((const unsigned*)((const char*)(gbase) + (voff)[_i]), (PG8_LAS unsigned*)(lds + (bufoff) + ldsw + _i * 8192), 16, 0, 0); } while (0)
#define PG8_LDA(dst, b, h) do { _Pragma("unroll") for (int m = 0; m < 4; ++m) { const bf16x8 x0_ = *(const PG8_LAS bf16x8*)(lds + PG8_SA(b, h) + aoff + m * 2048), x1_ = *(const PG8_LAS bf16x8*)(lds + PG8_SA(b, h) + aoff + m * 2048 + 1024); \
        if constexpr (F8) { dst##8[m] = cat8(x0_, x1_); } else { dst[m][0] = x0_; dst[m][1] = x1_; } } } while (0)
#define PG8_LDB(dst, b, h) do { _Pragma("unroll") for (int n = 0; n < 2; ++n) { const bf16x8 x0_ = *(const PG8_LAS bf16x8*)(lds + PG8_SB(b, h) + boff + n * 2048), x1_ = *(const PG8_LAS bf16x8*)(lds + PG8_SB(b, h) + boff + n * 2048 + 1024); \
        if constexpr (F8) { dst##8[n] = cat8(x0_, x1_); } else { dst[n][0] = x0_; dst[n][1] = x1_; } } } while (0)
#define PG8_MMA(ai, bj, At, Bt) do { __builtin_amdgcn_s_setprio(1); _Pragma("unroll") for (int m = 0; m < 4; ++m) _Pragma("unroll") for (int n = 0; n < 2; ++n) { \
        if constexpr (F8) { asm volatile("v_mfma_scale_f32_16x16x128_f8f6f4 %0, %1, %2, %0, %3, %3 op_sel_hi:[0,0,0]" : "+v"(acc[ai][bj][m][n]) : "v"(Bt##8[n]), "v"(At##8[m]), "v"(f8scale)); } \
        else { _Pragma("unroll") for (int k = 0; k < 2; ++k) acc[ai][bj][m][n] = __builtin_amdgcn_mfma_f32_16x16x32_bf16(Bt[n][k], At[m][k], acc[ai][bj][m][n], 0, 0, 0); } } \
        __builtin_amdgcn_s_setprio(0); } while (0)
#define PG8_WAIT_V(n) asm volatile("s_waitcnt vmcnt(" #n ")" ::: "memory")
#define PG8_WAIT_L(n) asm volatile("s_waitcnt lgkmcnt(" #n ")" ::: "memory")
#define PG8_BAR __builtin_amdgcn_s_barrier()
#define PG8_SCHED __builtin_amdgcn_sched_barrier(0)
    Unit cur, nxt; int ui = 0;
    if (!S.next(0, cur)) return;
    f32x4 acc[2][2][4][2];
#pragma unroll
    for (int a = 0; a < 2; ++a)
#pragma unroll
        for (int b = 0; b < 2; ++b)
#pragma unroll
            for (int m = 0; m < 4; ++m)
#pragma unroll
                for (int n = 0; n < 2; ++n) acc[a][b][m][n] = (f32x4){0.f, 0.f, 0.f, 0.f};
    const int f8scale = 0x7f7f7f7f;
    bf16x8 At[4][2], B0[2][2], B1[2][2]; v8i32 At8[4], B08[2], B18[2];
    const char* cA = (const char*)g.A + (size_t)cur.pm * tstep; const char* cB = (const char*)g.Bt + (size_t)cur.pn * tstep;
    S.a_ready(cur);
    if constexpr (SP2) {
        PG8_STAGE(PG8_SB(0, 0), cB, voffB); PG8_STAGE(PG8_SB(0, 1), cB + hstep, voffB); PG8_STAGE(PG8_SA(0, 0), cA, voffA); PG8_STAGE(PG8_SA(0, 1), cA + hstep, voffA);
        if (wr == 1) PG8_BAR;
        PG8_WAIT_V(2); PG8_BAR;
        PG8_STAGE(PG8_SB(1, 0), cB + kstep, voffB); PG8_STAGE(PG8_SA(1, 0), cA + kstep, voffA); PG8_STAGE(PG8_SB(1, 1), cB + hstep + kstep, voffB);
        PG8_WAIT_V(6); PG8_BAR;
    } else {
        PG8_STAGE(PG8_SB(0, 0), cB, voffB); PG8_STAGE(PG8_SA(0, 0), cA, voffA); PG8_STAGE(PG8_SB(0, 1), cB + hstep, voffB); PG8_STAGE(PG8_SA(0, 1), cA + hstep, voffA);
        if (wr == 1) PG8_BAR;
        PG8_WAIT_V(4); PG8_BAR;
        PG8_STAGE(PG8_SB(1, 0), cB + kstep, voffB); PG8_STAGE(PG8_SA(1, 0), cA + kstep, voffA); PG8_STAGE(PG8_SB(1, 1), cB + hstep + kstep, voffB);
        PG8_WAIT_V(6); PG8_BAR;
    }
    for (;;) {
        const bool has_next = S.next(ui + 1, nxt);
        const char* nA = has_next ? (const char*)g.A + (size_t)nxt.pm * tstep : cA; const char* nB = has_next ? (const char*)g.Bt + (size_t)nxt.pn * tstep : cB;
        for (int t = 0; t < nt; t += 2) {
            const bool last = (t == nt - 2);
            const char* a1 = cA + (size_t)(t + 1) * kstep;
            const char* a2 = last ? nA : cA + (size_t)(t + 2) * kstep; const char* b2 = last ? nB : cB + (size_t)(t + 2) * kstep;
            const char* a3 = a2 + kstep; const char* b3 = b2 + kstep;
            if (last && has_next) S.a_ready(nxt);
            if constexpr (SP2) {
            PG8_LDB(B0, 0, 0); PG8_LDB(B1, 0, 1); PG8_SCHED; PG8_LDA(At, 0, 0); PG8_STAGE(PG8_SA(1, 1), a1 + hstep, voffA);
            PG8_WAIT_V(8); PG8_WAIT_L(0); PG8_BAR; PG8_MMA(0, 0, At, B0); PG8_MMA(0, 1, At, B1); PG8_BAR; PG8_SCHED;
            PG8_LDA(At, 0, 1); PG8_STAGE(PG8_SB(0, 0), b2, voffB); PG8_STAGE(PG8_SB(0, 1), b2 + hstep, voffB); PG8_STAGE(PG8_SA(0, 0), a2, voffA);
            PG8_WAIT_V(8); PG8_WAIT_L(0); PG8_BAR; PG8_MMA(1, 0, At, B0); PG8_MMA(1, 1, At, B1); PG8_BAR; PG8_SCHED;
            PG8_LDB(B0, 1, 0); PG8_LDB(B1, 1, 1); PG8_SCHED; PG8_LDA(At, 1, 0); PG8_STAGE(PG8_SA(0, 1), a2 + hstep, voffA);
            PG8_WAIT_V(8); PG8_WAIT_L(0); PG8_BAR; PG8_MMA(0, 0, At, B0); PG8_MMA(0, 1, At, B1); PG8_BAR; PG8_SCHED;
            PG8_LDA(At, 1, 1); PG8_STAGE(PG8_SB(1, 0), b3, voffB); PG8_STAGE(PG8_SB(1, 1), b3 + hstep, voffB); PG8_STAGE(PG8_SA(1, 0), a3, voffA);
            PG8_WAIT_V(8); PG8_WAIT_L(0); PG8_BAR; PG8_MMA(1, 0, At, B0); PG8_MMA(1, 1, At, B1); PG8_BAR; PG8_SCHED;
            } else {
            PG8_LDB(B0, 0, 0); PG8_SCHED; PG8_LDA(At, 0, 0); PG8_STAGE(PG8_SA(1, 1), a1 + hstep, voffA);
            PG8_WAIT_L(8); PG8_BAR; PG8_WAIT_L(0); PG8_MMA(0, 0, At, B0); PG8_BAR; PG8_SCHED;
            PG8_LDB(B1, 0, 1); PG8_STAGE(PG8_SB(0, 0), b2, voffB);
            PG8_BAR; PG8_WAIT_L(0); PG8_MMA(0, 1, At, B1); PG8_BAR;
            PG8_LDA(At, 0, 1); PG8_STAGE(PG8_SA(0, 0), a2, voffA);
            PG8_BAR; PG8_WAIT_L(0); PG8_MMA(1, 0, At, B0); PG8_BAR; PG8_SCHED;
            PG8_STAGE(PG8_SB(0, 1), b2 + hstep, voffB);
            PG8_WAIT_V(6); PG8_BAR; PG8_MMA(1, 1, At, B1); PG8_BAR;
            PG8_LDB(B0, 1, 0); PG8_SCHED; PG8_LDA(At, 1, 0); PG8_STAGE(PG8_SA(0, 1), a2 + hstep, voffA);
            PG8_WAIT_L(8); PG8_BAR; PG8_WAIT_L(0); PG8_MMA(0, 0, At, B0); PG8_BAR; PG8_SCHED;
            PG8_LDB(B1, 1, 1); PG8_STAGE(PG8_SB(1, 0), b3, voffB);
            PG8_BAR; PG8_WAIT_L(0); PG8_MMA(0, 1, At, B1); PG8_BAR;
            PG8_LDA(At, 1, 1); PG8_STAGE(PG8_SA(1, 0), a3, voffA);
            PG8_BAR; PG8_WAIT_L(0); PG8_MMA(1, 0, At, B0); PG8_BAR; PG8_SCHED;
            PG8_STAGE(PG8_SB(1, 1), b3 + hstep, voffB);
            PG8_WAIT_V(6); PG8_BAR; PG8_MMA(1, 1, At, B1); PG8_BAR;
            }
        }
        if constexpr (ALIGN_EPI) { if (wr == 0) PG8_BAR; }
        if constexpr (F8) { asm volatile("s_nop 15\n\ts_nop 15" ::: "memory"); }
        if constexpr (!Epi::AFTER_DRAIN) { E(acc, cur, wr, wc, fr, fq); S.done(cur); }
        if (!has_next) break;
#pragma unroll
        for (int a = 0; a < 2; ++a)
#pragma unroll
            for (int b = 0; b < 2; ++b)
#pragma unroll
                for (int m = 0; m < 4; ++m)
#pragma unroll
                    for (int n = 0; n < 2; ++n) acc[a][b][m][n] = (f32x4){0.f, 0.f, 0.f, 0.f};
        cur = nxt; cA = nA; cB = nB; ++ui;
        if constexpr (ALIGN_EPI) { if (wr == 1) PG8_BAR; }
    }
    PG8_WAIT_V(0);
    if constexpr (!ALIGN_EPI) { if (wr == 0) PG8_BAR; }
    PG8_BAR;
    if constexpr (Epi::AFTER_DRAIN) { E.fused(acc, cur, wr, wc, fr, fq, lds, wid, lane); S.done(cur); }
#undef PG8_SA
#undef PG8_SB
#undef PG8_STAGE
#undef PG8_LDA
#undef PG8_LDB
#undef PG8_MMA
#undef PG8_WAIT_V
#undef PG8_WAIT_L
#undef PG8_BAR
#undef PG8_SCHED
}
}

constexpr int NB = 8, SEQ = 2048, DM = 1024, DEPTH = 4, T = NB * SEQ;
constexpr int DIN = 2756, NP = 2816;
constexpr int DFF = 2816, NE = 8, MODW = 6 * DM;
constexpr int C_QA = 0, C_KA = 384, C_VA = 448, C_QI = 512, C_KI = 768, C_QB = 832, C_KB = 1088, C_VB = 1344, C_QC = 1600, C_KC = 1984, C_VC = 2368, C_WI = 2752;
constexpr float LOG2E = 1.4426950408889634f;
constexpr float SCALE_A = 0.125f * LOG2E;
constexpr float SCALE_B = 0.17677669529663687f * LOG2E;

namespace pg8 {
__device__ __forceinline__ float row_rstd(const float* SSP, int row) {
    const f32x4* p = (const f32x4*)(SSP + (size_t)row * 16);
    const f32x4 a = p[0], b = p[1], c = p[2], d = p[3];
    const float s = ((a.x + a.y) + (a.z + a.w)) + ((b.x + b.y) + (b.z + b.w)) + ((c.x + c.y) + (c.z + c.w)) + ((d.x + d.y) + (d.z + d.w));
    return 1.f / sqrtf(s * (1.f / DM) + 1e-6f);
}
struct EpiProj {
    static constexpr bool PERM = true, AFTER_DRAIN = false;
    bf16_t* P; float* WI; const float* rope;
    const float* SSP; const float* bias;
    __device__ __forceinline__ void operator()(const f32x4 (&acc)[2][2][4][2], const Unit& u, int wr, int wc, int fr, int fq) const {
        const int row0 = u.pm * BM + wr * 64 + fr;
#pragma unroll
        for (int bj = 0; bj < 2; ++bj) {
            const int cw = u.pn * BM + bj * HALF + wc * 32;
            const int g = cw >> 6;
            const int c0 = cw + 8 * fq;
            int type = 0; float scale = 1.f;
            if (g < 6) { type = 1; scale = SCALE_A; }
            else if (g == 6) { type = 1; }
            else if (g == 7) { type = 0; }
            else if (g < 13) { type = 1; }
            else if (g < 17) { type = 2; scale = SCALE_B; }
            else if (g < 21) { type = 2; }
            else if (g < 25) { type = 0; }
            else if (g < 31) { type = 1; scale = SCALE_A; }
            else if (g < 37) { type = 1; }
            else { type = 0; }
            const bool rope64 = (type == 1) && ((wc & 1) == 0);
#pragma unroll
            for (int ai = 0; ai < 2; ++ai)
#pragma unroll
                for (int m = 0; m < 4; ++m) {
                    const int row = row0 + ai * HALF + m * 16;
                    f32x4 v0 = acc[ai][bj][m][0], v1 = acc[ai][bj][m][1];
                    if (SSP) { const float rs = row_rstd(SSP, row); const float* bp = bias + (size_t)(u.pm >> 3) * NP + c0; v0 = v0 * rs + *(const f32x4*)bp; v1 = v1 * rs + *(const f32x4*)(bp + 4); }
                    const float* rp = rope + (size_t)row * 24;
                    if (rope64) {
                        f32x4 p0, p1;
                        p0.x = __shfl_xor(v0.x, 16); p0.y = __shfl_xor(v0.y, 16); p0.z = __shfl_xor(v0.z, 16); p0.w = __shfl_xor(v0.w, 16);
                        p1.x = __shfl_xor(v1.x, 16); p1.y = __shfl_xor(v1.y, 16); p1.z = __shfl_xor(v1.z, 16); p1.w = __shfl_xor(v1.w, 16);
                        if (fq < 2) {
                            const f32x4 ca = *(const f32x4*)(rp), cb = *(const f32x4*)(rp + 4), sa = *(const f32x4*)(rp + 8), sb = *(const f32x4*)(rp + 12);
                            if (fq == 0) { v0 = v0 * ca - p0 * sa; v1 = v1 * cb - p1 * sb; }
                            else         { v0 = v0 * ca + p0 * sa; v1 = v1 * cb + p1 * sb; }
                        }
                    } else if (type == 2) {
                        if (fq == 0) {
                            const f32x4 c = *(const f32x4*)(rp + 16), s = *(const f32x4*)(rp + 20);
                            const f32x4 x1 = v0, x2 = v1;
                            v0 = x1 * c - x2 * s; v1 = x2 * c + x1 * s;
                        }
                    }
                    if (g == 43 && wc == 2 && fq == 0) *(f32x4*)(WI + (size_t)row * 4) = v0;
                    v0 = v0 * scale; v1 = v1 * scale;
                    u32x4 w; w.x = cvt_pk_bf16(v0[0], v0[1]); w.y = cvt_pk_bf16(v0[2], v0[3]); w.z = cvt_pk_bf16(v1[0], v1[1]); w.w = cvt_pk_bf16(v1[2], v1[3]);
                    *(u32x4*)(P + (size_t)row * NP + c0) = w;
                }
        }
    }
};
template <int NOUT, bool XF32 = false>
struct EpiResid {
    static constexpr bool PERM = true, AFTER_DRAIN = false;
    const void* xin; bf16_t* xout; const float* gate;
    void* XS; const float* gn; const float* scn; float* SSP; float f8h;
    __device__ __forceinline__ void operator()(const f32x4 (&acc)[2][2][4][2], const Unit& u, int wr, int wc, int fr, int fq) const {
        const int row0 = u.pm * BM + wr * 64 + fr, col0 = u.pn * BM + wc * 32 + 8 * fq;
        const int b = u.pm >> 3;
        f32x4 gv[2][2];
#pragma unroll
        for (int bj = 0; bj < 2; ++bj)
#pragma unroll
            for (int n = 0; n < 2; ++n) gv[bj][n] = *(const f32x4*)(gate + (size_t)b * MODW + col0 + bj * HALF + 4 * n) * (NOUT == 0 ? f8h : 1.f);
#pragma unroll
        for (int ai = 0; ai < 2; ++ai)
#pragma unroll
            for (int m = 0; m < 4; ++m) {
                const int row = row0 + ai * HALF + m * 16;
                bf16_t* xo = xout + (size_t)row * DM + col0;
#pragma unroll
                for (int bj = 0; bj < 2; ++bj) {
                    f32x4 x0, x1;
                    if (XF32) { const float* xi = (const float*)xin + (size_t)row * DM + col0 + bj * HALF; x0 = *(const f32x4*)xi; x1 = *(const f32x4*)(xi + 4); }
                    else { const u32x4 w_ = *(const u32x4*)((const bf16_t*)xin + (size_t)row * DM + col0 + bj * HALF);
                           x0 = (f32x4){__builtin_bit_cast(float, w_.x << 16), __builtin_bit_cast(float, w_.x & 0xffff0000u), __builtin_bit_cast(float, w_.y << 16), __builtin_bit_cast(float, w_.y & 0xffff0000u)};
                           x1 = (f32x4){__builtin_bit_cast(float, w_.z << 16), __builtin_bit_cast(float, w_.z & 0xffff0000u), __builtin_bit_cast(float, w_.w << 16), __builtin_bit_cast(float, w_.w & 0xffff0000u)}; }
                    const f32x4 n0 = x0 + gv[bj][0] * acc[ai][bj][m][0], n1 = x1 + gv[bj][1] * acc[ai][bj][m][1];
                    u32x4 w; w.x = cvt_pk_bf16(n0[0], n0[1]); w.y = cvt_pk_bf16(n0[2], n0[3]); w.z = cvt_pk_bf16(n1[0], n1[1]); w.w = cvt_pk_bf16(n1[2], n1[3]);
                    *(u32x4*)(xo + bj * HALF) = w;
                }
            }
    }
};
template <bool XF32, bool OUT8>
struct EpiResidNorm {
    static constexpr bool PERM = true, AFTER_DRAIN = true;
    const void* xin; bf16_t* xout; const float* gate;
    const float* gn; const float* modn; int off_sh, off_sc;
    void* H; float* slots; unsigned* cnt; float f8h;
    float accs;
    __device__ __forceinline__ void fused(f32x4 (&acc)[2][2][4][2], const Unit& u, int wr, int wc, int fr, int fq, PG8_LAS unsigned char* lds, int wid, int lane) const {
        PG8_LAS float* P = (PG8_LAS float*)lds;
        PG8_LAS float* S = (PG8_LAS float*)(lds + 8192);
        const int row0 = u.pm * BM + wr * 64 + fr, col0 = u.pn * BM + wc * 32 + 8 * fq;
        const int b = u.pm >> 3;
        {
            f32x4 gv[2][2];
#pragma unroll
            for (int bj = 0; bj < 2; ++bj)
#pragma unroll
                for (int n = 0; n < 2; ++n) gv[bj][n] = *(const f32x4*)(gate + (size_t)b * MODW + col0 + bj * HALF + 4 * n) * accs;
#pragma unroll
            for (int ai = 0; ai < 2; ++ai)
#pragma unroll
                for (int m = 0; m < 4; ++m) {
                    const int row = row0 + ai * HALF + m * 16;
                    float s = 0.f;
#pragma unroll
                    for (int bj = 0; bj < 2; ++bj) {
                        f32x4 x0, x1;
                        if (XF32) { const float* xi = (const float*)xin + (size_t)row * DM + col0 + bj * HALF; x0 = *(const f32x4*)xi; x1 = *(const f32x4*)(xi + 4); }
                        else { const u32x4 w_ = *(const u32x4*)((const bf16_t*)xin + (size_t)row * DM + col0 + bj * HALF);
                               x0 = (f32x4){__builtin_bit_cast(float, w_.x << 16), __builtin_bit_cast(float, w_.x & 0xffff0000u), __builtin_bit_cast(float, w_.y << 16), __builtin_bit_cast(float, w_.y & 0xffff0000u)};
                               x1 = (f32x4){__builtin_bit_cast(float, w_.z << 16), __builtin_bit_cast(float, w_.z & 0xffff0000u), __builtin_bit_cast(float, w_.w << 16), __builtin_bit_cast(float, w_.w & 0xffff0000u)}; }
                        const f32x4 n0 = x0 + gv[bj][0] * acc[ai][bj][m][0], n1 = x1 + gv[bj][1] * acc[ai][bj][m][1];
                        acc[ai][bj][m][0] = n0; acc[ai][bj][m][1] = n1;
                        s += ((n0[0] * n0[0] + n0[1] * n0[1]) + (n0[2] * n0[2] + n0[3] * n0[3])) + ((n1[0] * n1[0] + n1[1] * n1[1]) + (n1[2] * n1[2] + n1[3] * n1[3]));
                    }
                    s += __shfl_xor(s, 16); s += __shfl_xor(s, 32);
                    if (fq == 0) P[(ai * HALF + wr * 64 + m * 16 + fr) * 4 + wc] = s;
                }
        }
        asm volatile("s_waitcnt lgkmcnt(0)" ::: "memory"); __builtin_amdgcn_s_barrier(); asm volatile("" ::: "memory");
        const int rl = wid * 32 + (lane & 31);
        if (lane < 32) {
            const f32x4 p = *(const PG8_LAS f32x4*)(P + rl * 4);
            __hip_atomic_store((unsigned*)slots + (size_t)(u.pm * BM + rl) * 4 + u.pn, __builtin_bit_cast(unsigned, (p[0] + p[1]) + (p[2] + p[3])), __ATOMIC_RELAXED, __HIP_MEMORY_SCOPE_AGENT);
        }
        asm volatile("s_waitcnt vmcnt(0)" ::: "memory");
        if (lane == 0) __hip_atomic_fetch_add(cnt + 8 * u.pm, 1u, __ATOMIC_RELAXED, __HIP_MEMORY_SCOPE_AGENT);
        f32x4 gsv[2][2], shv[2][2];
#pragma unroll
        for (int bj = 0; bj < 2; ++bj)
#pragma unroll
            for (int n = 0; n < 2; ++n) { const int col = col0 + bj * HALF + 4 * n;
                gsv[bj][n] = *(const f32x4*)(gn + col) * (*(const f32x4*)(modn + (size_t)b * MODW + off_sc + col) + 1.f); shv[bj][n] = *(const f32x4*)(modn + (size_t)b * MODW + off_sh + col); }
        if (wid == 0) {
            for (;;) {
                if ((unsigned)__builtin_amdgcn_readfirstlane(__hip_atomic_load(cnt + 8 * u.pm, __ATOMIC_RELAXED, __HIP_MEMORY_SCOPE_AGENT)) >= 32u) break;
                __builtin_amdgcn_s_sleep(2);
            }
            __builtin_amdgcn_fence(__ATOMIC_ACQUIRE, "agent");
        }
        asm volatile("s_waitcnt vmcnt(0) lgkmcnt(0)" ::: "memory"); __builtin_amdgcn_s_barrier(); asm volatile("" ::: "memory");
        if (lane < 32) {
            const unsigned* sl = (const unsigned*)slots + (size_t)(u.pm * BM + rl) * 4; float t = 0.f;
#pragma unroll
            for (int k = 0; k < 4; ++k) t += __builtin_bit_cast(float, __hip_atomic_load(sl + k, __ATOMIC_RELAXED, __HIP_MEMORY_SCOPE_AGENT));
            S[rl] = 1.f / sqrtf(t * (1.f / DM) + 1e-6f);
        }
        asm volatile("s_waitcnt vmcnt(0) lgkmcnt(0)" ::: "memory"); __builtin_amdgcn_s_barrier(); asm volatile("" ::: "memory");
#pragma unroll
        for (int ai = 0; ai < 2; ++ai)
#pragma unroll
            for (int m = 0; m < 4; ++m) {
                const int rt = ai * HALF + wr * 64 + m * 16 + fr; const float r = S[rt];
                const size_t row = (size_t)(u.pm * BM + rt);
#pragma unroll
                for (int bj = 0; bj < 2; ++bj) {
                    const f32x4 n0 = acc[ai][bj][m][0], n1 = acc[ai][bj][m][1];
                    { u32x4 w; w.x = cvt_pk_bf16(n0[0], n0[1]); w.y = cvt_pk_bf16(n0[2], n0[3]); w.z = cvt_pk_bf16(n1[0], n1[1]); w.w = cvt_pk_bf16(n1[2], n1[3]);
                      *(u32x4*)(xout + row * DM + col0 + bj * HALF) = w; }
                    const f32x4 h0 = (n0 * r) * gsv[bj][0] + shv[bj][0], h1 = (n1 * r) * gsv[bj][1] + shv[bj][1];
                    if (OUT8) { unsigned w0 = 0u, w1 = 0u;
                        w0 = __builtin_amdgcn_cvt_pk_fp8_f32(h0[0] * f8h, h0[1] * f8h, w0, false); w0 = __builtin_amdgcn_cvt_pk_fp8_f32(h0[2] * f8h, h0[3] * f8h, w0, true);
                        w1 = __builtin_amdgcn_cvt_pk_fp8_f32(h1[0] * f8h, h1[1] * f8h, w1, false); w1 = __builtin_amdgcn_cvt_pk_fp8_f32(h1[2] * f8h, h1[3] * f8h, w1, true);
                        *(unsigned long long*)((unsigned char*)H + row * DM + col0 + bj * HALF) = (unsigned long long)w0 | ((unsigned long long)w1 << 32);
                    } else { u32x4 w; w.x = cvt_pk_bf16(h0[0], h0[1]); w.y = cvt_pk_bf16(h0[2], h0[3]); w.z = cvt_pk_bf16(h1[0], h1[1]); w.w = cvt_pk_bf16(h1[2], h1[3]);
                        *(u32x4*)((bf16_t*)H + row * DM + col0 + bj * HALF) = w; }
                }
            }
    }
};
struct EpiResidNormRoute {
    static constexpr bool PERM = true, AFTER_DRAIN = true;
    const void* xin; bf16_t* xout; const float* gate;
    const float* gn; const float* modn; int off_sh, off_sc;
    void* H; float* slots; unsigned* cnt; float f8h;
    const float* wrt; int* LIST; int* ENTI; float* ENTW; unsigned* gcnt;
    const float* bias8;
    __device__ __forceinline__ void fused(f32x4 (&acc)[2][2][4][2], const Unit& u, int wr, int wc, int fr, int fq, PG8_LAS unsigned char* lds, int wid, int lane) const {
        PG8_LAS float* P = (PG8_LAS float*)lds;
        PG8_LAS float* S = (PG8_LAS float*)(lds + 49152);
        PG8_LAS float* GW = S + 256;
        PG8_LAS int* le = (PG8_LAS int*)(GW + 2048);
        PG8_LAS int* lp = le + 512;
        PG8_LAS float* lw = (PG8_LAS float*)(lp + 512);
        PG8_LAS unsigned* lcnt = (PG8_LAS unsigned*)(lw + 512);
        PG8_LAS unsigned* lbase = lcnt + 8;
        const int tid = wid * 64 + lane;
        const int row0 = u.pm * BM + wr * 64 + fr, col0 = u.pn * BM + wc * 32 + 8 * fq;
        const int b = u.pm >> 3;
        if (tid < 8) lcnt[tid] = 0u;
        const int c4_ = u.pn * BM + 4 * (tid & 63);
        const f32x4 st_g = *(const f32x4*)(gn + c4_), st_sc = *(const f32x4*)(modn + (size_t)b * MODW + off_sc + c4_), st_w = *(const f32x4*)(wrt + (tid >> 6) * DM + c4_);
        {
            f32x4 gv[2][2];
#pragma unroll
            for (int bj = 0; bj < 2; ++bj)
#pragma unroll
                for (int n = 0; n < 2; ++n) gv[bj][n] = *(const f32x4*)(gate + (size_t)b * MODW + col0 + bj * HALF + 4 * n);
#pragma unroll
            for (int ai = 0; ai < 2; ++ai)
#pragma unroll
                for (int m = 0; m < 4; ++m) {
                    const int row = row0 + ai * HALF + m * 16;
                    float s = 0.f;
#pragma unroll
                    for (int bj = 0; bj < 2; ++bj) {
                        const u32x4 w_ = *(const u32x4*)((const bf16_t*)xin + (size_t)row * DM + col0 + bj * HALF);
                        const f32x4 x0 = (f32x4){__builtin_bit_cast(float, w_.x << 16), __builtin_bit_cast(float, w_.x & 0xffff0000u), __builtin_bit_cast(float, w_.y << 16), __builtin_bit_cast(float, w_.y & 0xffff0000u)};
                        const f32x4 x1 = (f32x4){__builtin_bit_cast(float, w_.z << 16), __builtin_bit_cast(float, w_.z & 0xffff0000u), __builtin_bit_cast(float, w_.w << 16), __builtin_bit_cast(float, w_.w & 0xffff0000u)};
                        const f32x4 n0 = x0 + gv[bj][0] * acc[ai][bj][m][0], n1 = x1 + gv[bj][1] * acc[ai][bj][m][1];
                        acc[ai][bj][m][0] = n0; acc[ai][bj][m][1] = n1;
                        s += ((n0[0] * n0[0] + n0[1] * n0[1]) + (n0[2] * n0[2] + n0[3] * n0[3])) + ((n1[0] * n1[0] + n1[1] * n1[1]) + (n1[2] * n1[2] + n1[3] * n1[3]));
                    }
                    s += __shfl_xor(s, 16); s += __shfl_xor(s, 32);
                    if (fq == 0) P[((ai * HALF + wr * 64 + m * 16 + fr) * 4 + wc) * 12] = s;
                }
        }
        f32x4 gsv[2][2];
#pragma unroll
        for (int bj = 0; bj < 2; ++bj)
#pragma unroll
            for (int n = 0; n < 2; ++n) { const int col = col0 + bj * HALF + 4 * n; gsv[bj][n] = *(const f32x4*)(gn + col) * (*(const f32x4*)(modn + (size_t)b * MODW + off_sc + col) + 1.f); }
        *(PG8_LAS f32x4*)(GW + (tid >> 6) * 256 + 4 * (tid & 63)) = (st_g * (st_sc + 1.f)) * st_w;
        asm volatile("s_waitcnt vmcnt(0) lgkmcnt(0)" ::: "memory"); __builtin_amdgcn_s_barrier(); asm volatile("" ::: "memory");
#pragma unroll 1
        for (int e = 0; e < 8; ++e) {
            f32x4 gw[2][2];
#pragma unroll
            for (int bj = 0; bj < 2; ++bj)
#pragma unroll
                for (int n = 0; n < 2; ++n) gw[bj][n] = *(const PG8_LAS f32x4*)(GW + e * 256 + wc * 32 + 8 * fq + bj * HALF + 4 * n);
            float dv[8];
#pragma unroll
            for (int ai = 0; ai < 2; ++ai)
#pragma unroll
                for (int m = 0; m < 4; ++m) {
                    const f32x4 d4 = (acc[ai][0][m][0] * gw[0][0] + acc[ai][0][m][1] * gw[0][1]) + (acc[ai][1][m][0] * gw[1][0] + acc[ai][1][m][1] * gw[1][1]);
                    dv[ai * 4 + m] = (d4[0] + d4[1]) + (d4[2] + d4[3]);
                }
#pragma unroll
            for (int k = 0; k < 8; ++k) dv[k] += __shfl_xor(dv[k], 16);
#pragma unroll
            for (int k = 0; k < 8; ++k) dv[k] += __shfl_xor(dv[k], 32);
            if (fq == 0) {
#pragma unroll
                for (int ai = 0; ai < 2; ++ai)
#pragma unroll
                    for (int m = 0; m < 4; ++m) P[((ai * HALF + wr * 64 + m * 16 + fr) * 4 + wc) * 12 + 1 + e] = dv[ai * 4 + m];
            }
        }
        asm volatile("s_waitcnt lgkmcnt(0)" ::: "memory"); __builtin_amdgcn_s_barrier(); asm volatile("" ::: "memory");
        const int rl = wid * 32 + (lane & 31);
        unsigned long long* sl = (unsigned long long*)slots + ((size_t)(u.pm * BM + rl) * 4) * 6;
        if (lane < 32) {
            f32x4 t0 = {0.f, 0.f, 0.f, 0.f}, t1 = t0, t2 = t0;
#pragma unroll
            for (int w = 0; w < 4; ++w) { const PG8_LAS f32x4* p = (const PG8_LAS f32x4*)(P + (rl * 4 + w) * 12); t0 += p[0]; t1 += p[1]; t2 += p[2]; }
            unsigned long long* so = sl + u.pn * 6;
            const float f0 = t0[0], f1 = t0[1], f2 = t0[2], f3 = t0[3], f4 = t1[0], f5 = t1[1], f6 = t1[2], f7 = t1[3], f8 = t2[0];
#define PK64_(a, b) ((unsigned long long)__builtin_bit_cast(unsigned, a) | ((unsigned long long)__builtin_bit_cast(unsigned, b) << 32))
            __hip_atomic_store(so + 0, PK64_(f0, f1), __ATOMIC_RELAXED, __HIP_MEMORY_SCOPE_AGENT);
            __hip_atomic_store(so + 1, PK64_(f2, f3), __ATOMIC_RELAXED, __HIP_MEMORY_SCOPE_AGENT);
            __hip_atomic_store(so + 2, PK64_(f4, f5), __ATOMIC_RELAXED, __HIP_MEMORY_SCOPE_AGENT);
            __hip_atomic_store(so + 3, PK64_(f6, f7), __ATOMIC_RELAXED, __HIP_MEMORY_SCOPE_AGENT);
            __hip_atomic_store(so + 4, (unsigned long long)__builtin_bit_cast(unsigned, f8), __ATOMIC_RELAXED, __HIP_MEMORY_SCOPE_AGENT);
#undef PK64_
        }
        asm volatile("s_waitcnt vmcnt(0)" ::: "memory");
        if (lane == 0) __hip_atomic_fetch_add(cnt + 8 * u.pm, 1u, __ATOMIC_RELAXED, __HIP_MEMORY_SCOPE_AGENT);
        int vz_; asm volatile("v_mov_b32 %0, 0" : "=v"(vz_));
        const f32x4 bsa = *(const f32x4*)(bias8 + b * 8 + vz_), bsb = *(const f32x4*)(bias8 + b * 8 + 4 + vz_);
        if (wid == 0) {
            for (;;) {
                if ((unsigned)__builtin_amdgcn_readfirstlane(__hip_atomic_load(cnt + 8 * u.pm, __ATOMIC_RELAXED, __HIP_MEMORY_SCOPE_AGENT)) >= 32u) break;
                __builtin_amdgcn_s_sleep(2);
            }
            __builtin_amdgcn_fence(__ATOMIC_ACQUIRE, "agent");
        }
        asm volatile("s_waitcnt vmcnt(0) lgkmcnt(0)" ::: "memory"); __builtin_amdgcn_s_barrier(); asm volatile("" ::: "memory");
        if (lane < 32) {
            float t[10];
#pragma unroll
            for (int k = 0; k < 10; ++k) t[k] = 0.f;
#pragma unroll
            for (int o = 0; o < 4; ++o)
#pragma unroll
                for (int k2 = 0; k2 < 5; ++k2) { const unsigned long long w = __hip_atomic_load(sl + o * 6 + k2, __ATOMIC_RELAXED, __HIP_MEMORY_SCOPE_AGENT);
                    t[2 * k2] += __builtin_bit_cast(float, (unsigned)w); t[2 * k2 + 1] += __builtin_bit_cast(float, (unsigned)(w >> 32)); }
            const float rstd = 1.f / sqrtf(t[0] * (1.f / DM) + 1e-6f);
            S[rl] = rstd;
            if (u.pn == 0) {
                float pe[8];
#pragma unroll
                for (int e = 0; e < 8; ++e) pe[e] = rstd * t[1 + e] + (e < 4 ? bsa[e & 3] : bsb[e & 3]);
                int i0 = 0; float v0 = pe[0];
#pragma unroll
                for (int e = 1; e < 8; ++e) if (pe[e] > v0) { v0 = pe[e]; i0 = e; }
                int i1 = -1; float v1 = -INFINITY;
#pragma unroll
                for (int e = 0; e < 8; ++e) if (e != i0 && pe[e] > v1) { v1 = pe[e]; i1 = e; }
                const float e1 = __expf(v1 - v0), w0 = 1.f / (1.f + e1), w1 = e1 / (1.f + e1);
                le[2 * rl] = i0; le[2 * rl + 1] = i1; lw[2 * rl] = w0; lw[2 * rl + 1] = w1;
                lp[2 * rl] = (int)__hip_atomic_fetch_add(lcnt + i0, 1u, __ATOMIC_RELAXED, __HIP_MEMORY_SCOPE_WORKGROUP);
                lp[2 * rl + 1] = (int)__hip_atomic_fetch_add(lcnt + i1, 1u, __ATOMIC_RELAXED, __HIP_MEMORY_SCOPE_WORKGROUP);
            }
        }
        asm volatile("s_waitcnt vmcnt(0) lgkmcnt(0)" ::: "memory"); __builtin_amdgcn_s_barrier(); asm volatile("" ::: "memory");
        if (u.pn == 0) {
            if (tid < 8) lbase[tid] = __hip_atomic_fetch_add(gcnt + tid, lcnt[tid], __ATOMIC_RELAXED, __HIP_MEMORY_SCOPE_AGENT);
            asm volatile("s_waitcnt vmcnt(0) lgkmcnt(0)" ::: "memory"); __builtin_amdgcn_s_barrier(); asm volatile("" ::: "memory");
            { const int m = u.pm * BM + (tid >> 1), k = tid & 1, e = le[tid], p = (int)lbase[e] + lp[tid];
              LIST[(size_t)e * T + p] = m; ENTI[(size_t)m * 4 + 2 * k] = e; ENTI[(size_t)m * 4 + 2 * k + 1] = p; ENTW[(size_t)m * 2 + k] = lw[tid]; }
        }
        f32x4 shv[2][2];
#pragma unroll
        for (int bj = 0; bj < 2; ++bj)
#pragma unroll
            for (int n = 0; n < 2; ++n) shv[bj][n] = *(const f32x4*)(modn + (size_t)b * MODW + off_sh + col0 + bj * HALF + 4 * n);
#pragma unroll
        for (int ai = 0; ai < 2; ++ai)
#pragma unroll
            for (int m = 0; m < 4; ++m) {
                const int rt = ai * HALF + wr * 64 + m * 16 + fr; const float r = S[rt];
                const size_t row = (size_t)(u.pm * BM + rt);
#pragma unroll
                for (int bj = 0; bj < 2; ++bj) {
                    const f32x4 n0 = acc[ai][bj][m][0], n1 = acc[ai][bj][m][1];
                    { u32x4 w; w.x = cvt_pk_bf16(n0[0], n0[1]); w.y = cvt_pk_bf16(n0[2], n0[3]); w.z = cvt_pk_bf16(n1[0], n1[1]); w.w = cvt_pk_bf16(n1[2], n1[3]);
                      *(u32x4*)(xout + row * DM + col0 + bj * HALF) = w; }
                    const f32x4 h0 = (n0 * r) * gsv[bj][0] + shv[bj][0], h1 = (n1 * r) * gsv[bj][1] + shv[bj][1];
                    unsigned w0 = 0u, w1 = 0u;
                    w0 = __builtin_amdgcn_cvt_pk_fp8_f32(h0[0] * f8h, h0[1] * f8h, w0, false); w0 = __builtin_amdgcn_cvt_pk_fp8_f32(h0[2] * f8h, h0[3] * f8h, w0, true);
                    w1 = __builtin_amdgcn_cvt_pk_fp8_f32(h1[0] * f8h, h1[1] * f8h, w1, false); w1 = __builtin_amdgcn_cvt_pk_fp8_f32(h1[2] * f8h, h1[3] * f8h, w1, true);
                    *(unsigned long long*)((unsigned char*)H + row * DM + col0 + bj * HALF) = (unsigned long long)w0 | ((unsigned long long)w1 << 32);
                }
            }
    }
};
struct EpiSwiGLU {
    static constexpr bool PERM = true, AFTER_DRAIN = false;
    bf16_t* O; int nmod; float s;
    const float* SSP; const float* bias;
    float out8;
    __device__ __forceinline__ void operator()(const f32x4 (&acc)[2][2][4][2], const Unit& u, int wr, int wc, int fr, int fq) const {
        const int pnl = nmod ? (u.pn % nmod) : u.pn;
        const int row0 = u.pm * BM + wr * 64 + fr, f0 = pnl * HALF + wc * 32 + 8 * fq;
        const float c1 = -s * LOG2E, kq = 1.f / (s * s * (out8 != 0.f ? out8 : 1.f));
#pragma unroll
        for (int ai = 0; ai < 2; ++ai)
#pragma unroll
            for (int m = 0; m < 4; ++m) {
                const int row = row0 + ai * HALF + m * 16;
                float r[8];
#pragma unroll
                for (int n = 0; n < 2; ++n) {
                    const f32x4 ag = acc[ai][0][m][n], au = acc[ai][1][m][n];
#pragma unroll
                    for (int i = 0; i < 4; ++i) {
                        const float g_ = ag[i], u_ = au[i];
                        const float e_ = __builtin_amdgcn_exp2f(g_ * c1);
                        const float sg_ = __builtin_amdgcn_rcpf(__builtin_fmaf(e_, kq, kq));
                        r[4 * n + i] = (g_ * u_) * sg_;
                    }
                }
                if (out8 != 0.f) {
#pragma unroll
                    for (int i = 0; i < 8; ++i) r[i] = fminf(fmaxf(r[i], -440.f), 440.f);
                    unsigned w0 = 0u, w1 = 0u;
                    w0 = __builtin_amdgcn_cvt_pk_fp8_f32(r[0], r[1], w0, false); w0 = __builtin_amdgcn_cvt_pk_fp8_f32(r[2], r[3], w0, true);
                    w1 = __builtin_amdgcn_cvt_pk_fp8_f32(r[4], r[5], w1, false); w1 = __builtin_amdgcn_cvt_pk_fp8_f32(r[6], r[7], w1, true);
                    *(unsigned long long*)((unsigned char*)O + (size_t)row * DFF + f0) = (unsigned long long)w0 | ((unsigned long long)w1 << 32);
                } else {
                    u32x4 w; w.x = cvt_pk_bf16(r[0], r[1]); w.y = cvt_pk_bf16(r[2], r[3]); w.z = cvt_pk_bf16(r[4], r[5]); w.w = cvt_pk_bf16(r[6], r[7]);
                    *(u32x4*)(O + (size_t)row * DFF + f0) = w;
                }
            }
    }
};
struct EpiStoreBf16 {
    static constexpr bool PERM = true, AFTER_DRAIN = false;
    bf16_t* O; int ldc; int nmod; float s;
    __device__ __forceinline__ void operator()(const f32x4 (&acc)[2][2][4][2], const Unit& u, int wr, int wc, int fr, int fq) const {
        const int pnl = nmod ? (u.pn % nmod) : u.pn;
        const int row0 = u.pm * BM + wr * 64 + fr, col0 = pnl * BM + wc * 32 + 8 * fq;
#pragma unroll
        for (int ai = 0; ai < 2; ++ai)
#pragma unroll
            for (int m = 0; m < 4; ++m) {
                bf16_t* rowp = O + (size_t)(row0 + ai * HALF + m * 16) * ldc + col0;
#pragma unroll
                for (int bj = 0; bj < 2; ++bj) { const f32x4 v0 = acc[ai][bj][m][0] * s, v1 = acc[ai][bj][m][1] * s;
                    u32x4 w; w.x = cvt_pk_bf16(v0[0], v0[1]); w.y = cvt_pk_bf16(v0[2], v0[3]); w.z = cvt_pk_bf16(v1[0], v1[1]); w.w = cvt_pk_bf16(v1[2], v1[3]);
                    *(u32x4*)(rowp + bj * HALF) = w; }
            }
    }
};
struct MoeOrder {
    int nN, ntile, G, c, t1, t2, t3, t4, t5, t6, t7;
    __device__ __forceinline__ bool next(int i, Unit& u) const {
        int tile, pn;
        if ((G & 7) == 0) {
            const int xc = c & 7, nh = nN >> 1, Lx = i * (G >> 3) + (c >> 3), ti = Lx / nh;
            tile = 4 * ti + (xc & 3); pn = (Lx - ti * nh) + nh * (xc >> 2);
            if (tile >= ntile) return false;
        } else {
            const int L = i * G + c; if (L >= ntile * nN) return false;
            tile = L / nN; pn = L - tile * nN;
        }
        const int e = (tile >= t1) + (tile >= t2) + (tile >= t3) + (tile >= t4) + (tile >= t5) + (tile >= t6) + (tile >= t7);
        u.pm = tile; u.pn = e * nN + pn; return true;
    }
    __device__ __forceinline__ void a_ready(const Unit&) const {}
    __device__ __forceinline__ void done(const Unit&) const {}
};
}

#ifndef PROBE_P0
#define PROBE_P0 0
#endif
#ifndef PROBE_ATT
#define PROBE_ATT 0
#endif
#ifndef PROBE_IDX
#define PROBE_IDX 0
#endif
#ifndef PROBE_PROJ
#define PROBE_PROJ 0
#endif
#ifndef PROBE_MUP
#define PROBE_MUP 0
#endif
#ifndef PROBE_MDN
#define PROBE_MDN 0
#endif
#ifndef PROBE_DUP
#define PROBE_DUP 0
#endif
#ifndef PROBE_BAR
#define PROBE_BAR 0
#endif
#ifndef PROBE_NORM
#define PROBE_NORM 0
#endif
#ifndef PROBE_ATT2
#define PROBE_ATT2 0
#endif
#ifndef PROBE_APV
#define PROBE_APV 0
#endif
#ifndef PROBE_MUPL
#define PROBE_MUPL 0
#endif
#ifndef PROBE_GATH
#define PROBE_GATH 0
#endif
#ifndef PROBE_FIN
#define PROBE_FIN 0
#endif
#ifndef PROBE_ROUTE
#define PROBE_ROUTE 0
#endif
#ifndef PROBE_OUT
#define PROBE_OUT 0
#endif
#ifndef PROBE_DDN
#define PROBE_DDN 0
#endif
#ifndef PROBE_BIS
#define PROBE_BIS 0
#endif
#ifndef PROBE_AEXP
#define PROBE_AEXP 0
#endif
#ifndef PROBE_AQK
#define PROBE_AQK 0
#endif
#ifndef PROBE_SEL
#define PROBE_SEL 0
#endif
#ifndef PROBE_SC
#define PROBE_SC 0
#endif
#ifndef PROBE_KM
#define PROBE_KM 0
#endif
constexpr size_t MiB = 1u << 20;
constexpr size_t WS_CTL = 0, CTL_ZERO_BYTES = 64 * 1024;
constexpr size_t WS_MOD = 1 * MiB;
constexpr size_t WS_ROPE = 2 * MiB;
constexpr size_t WS_KMEAN = 4 * MiB;
constexpr size_t WS_LIST = 5 * MiB;
constexpr size_t WS_ENTI = 7 * MiB;
constexpr size_t WS_ENTW = 7 * MiB + 512 * 1024;
constexpr size_t WS_WI = 6 * MiB;
constexpr size_t WS_MASKA = 8 * MiB;
constexpr size_t WS_WIN = 12 * MiB;
constexpr size_t WS_WOUT = 34 * MiB;
constexpr size_t WS_WGU = 42 * MiB;
constexpr size_t WS_WDN = 64 * MiB;
constexpr size_t WS_EGU = 76 * MiB;
constexpr size_t WS_EDN = 252 * MiB;
constexpr size_t WS_X = 340 * MiB;
constexpr size_t WS_H = 404 * MiB;
constexpr size_t WS_PROJ = 436 * MiB;
constexpr size_t WS_Y = 524 * MiB;
constexpr size_t WS_ACT = 556 * MiB;
constexpr size_t WS_ACTM = 436 * MiB;
constexpr size_t WS_R = 623 * MiB;
constexpr size_t WS_HG = 692 * MiB;
constexpr size_t WS_SSP1 = 760 * MiB, WS_SSP2 = 761 * MiB;
constexpr size_t WS_WRT = 760 * MiB;
constexpr size_t WS_RB8 = 760 * MiB + 512 * 1024;
constexpr size_t WS_BIASP = 762 * MiB;
constexpr size_t WS_BIASU = 762 * MiB + 512 * 1024;
constexpr size_t WS_END = 764 * MiB;
constexpr size_t SZ_WIN = (size_t)NP * DM * 2, SZ_WOUT = (size_t)DM * DM * 2, SZ_WGU = (size_t)2 * DFF * DM * 2, SZ_WGU8 = (size_t)2 * DFF * DM, SZ_WDN = (size_t)DM * DFF * 2, SZ_WDN8 = (size_t)DM * DFF;
constexpr int CW_BAR = 4096;

constexpr int RING_BYTES = 131072;
constexpr int MISC_OFF = RING_BYTES + 320;
constexpr int MOE_TB_OFF = RING_BYTES, MOE_CN_OFF = RING_BYTES + 64;
constexpr int LDS_BYTES = 147456;
constexpr int NWAVES = 8, NTHR = 512;

#define GAS __attribute__((address_space(1)))
#define LAS __attribute__((address_space(3)))
typedef unsigned short bf16;
typedef float f32x4 __attribute__((ext_vector_type(4)));
typedef unsigned u32x4 __attribute__((ext_vector_type(4)));
typedef unsigned u32x2 __attribute__((ext_vector_type(2)));
typedef GAS unsigned gu32;

__device__ __forceinline__ unsigned f2bf(float f) { unsigned u = __builtin_bit_cast(unsigned, f); return (u + 0x7fffu + ((u >> 16) & 1u)) >> 16; }
__device__ __forceinline__ unsigned pk2(float lo, float hi) { return f2bf(lo) | (f2bf(hi) << 16); }
__device__ __forceinline__ float bflo(unsigned w) { return __builtin_bit_cast(float, w << 16); }
__device__ __forceinline__ float bfhi(unsigned w) { return __builtin_bit_cast(float, w & 0xffff0000u); }
__device__ __forceinline__ int vzero() { int z; asm volatile("v_mov_b32 %0, 0" : "=v"(z)); return z; }
__device__ __forceinline__ float wave_sum(float v) {
#pragma unroll
    for (int o = 1; o < 64; o <<= 1) v += __shfl_xor(v, o);
    return v;
}

#define XB_TMO      128
#define XB_XCNT(j)  (256  + 64 * (j))
#define XB_XSUB(j)  (1280 + 64 * (j))
#define XB_XGEN(j)  (2304 + 64 * (j))
#define XB_TOP      3328
#define XB_TOPGEN   3392
#define XCD_BAR_WORDS 3456
#define XB_SPIN_CAP (1u << 18)

__device__ __forceinline__ unsigned xb_ld(unsigned* p)              { return __hip_atomic_load(p, __ATOMIC_RELAXED, __HIP_MEMORY_SCOPE_AGENT); }
__device__ __forceinline__ unsigned xb_add(unsigned* p, unsigned v) { return __hip_atomic_fetch_add(p, v, __ATOMIC_RELAXED, __HIP_MEMORY_SCOPE_AGENT); }
__device__ __forceinline__ unsigned xb_xcc_id() { return (unsigned)__builtin_amdgcn_s_getreg((3 << 11) | 20) & 0xFu; }
#define XB_SPIN(cond, bar) do { unsigned _sp = 0; while (cond) { __builtin_amdgcn_s_sleep(1); \
    if ((++_sp & 255u) == 0u) { if (xb_ld(&(bar)[XB_TMO])) break; if (_sp > XB_SPIN_CAP) { atomicAdd(&(bar)[XB_TMO], 1u); break; } } } } while (0)

struct XcdBarrier {
    unsigned* bar; unsigned x;
    volatile LAS unsigned* st;
};

__device__ __forceinline__ XcdBarrier xcd_barrier_post(unsigned* bar, volatile LAS unsigned* st) {
    XcdBarrier b; b.bar = bar; b.x = xb_xcc_id(); b.st = st;
    if (threadIdx.x == 0) (void)xb_add(&bar[XB_XCNT(b.x)], 1u);
    return b;
}
__device__ __forceinline__ void xcd_barrier_complete(unsigned* bar, unsigned x, unsigned& nloc, unsigned& nx) {
    const unsigned G = gridDim.x * gridDim.y * gridDim.z;
    unsigned sum, cnt, mine, sp = 0u;
    for (;;) {
        sum = 0u; cnt = 0u; mine = 0u;
#pragma unroll
        for (unsigned j = 0; j < 16; ++j) { const unsigned c = xb_ld(&bar[XB_XCNT(j)]); sum += c; cnt += (c > 0u) ? 1u : 0u; mine = (j == x) ? c : mine; }
        if (sum == G) break;
        __builtin_amdgcn_s_sleep(1);
        if ((++sp & 255u) == 0u) { if (xb_ld(&bar[XB_TMO])) break; if (sp > XB_SPIN_CAP) { atomicAdd(&bar[XB_TMO], 1u); break; } }
    }
    nloc = mine > 0u ? mine : 1u; nx = cnt > 0u ? cnt : 1u;
}

__device__ __forceinline__ void xcd_barrier(const XcdBarrier& b) {
    asm volatile("s_waitcnt vmcnt(0)" ::: "memory");
    __syncthreads();
    if (threadIdx.x == 0) {
        unsigned* bar = b.bar;
        __builtin_amdgcn_s_waitcnt(0);
        unsigned nloc = b.st[0], nx = b.st[1];
        if (nloc == 0u) { xcd_barrier_complete(bar, b.x, nloc, nx); b.st[0] = nloc; b.st[1] = nx; }
        const unsigned old = xb_add(&bar[XB_XSUB(b.x)], 1u);
        const unsigned gen = old / nloc;
        if (old + 1u == (gen + 1u) * nloc) {
            __builtin_amdgcn_fence(__ATOMIC_RELEASE, "agent");
            asm volatile("s_waitcnt vmcnt(0)" ::: "memory");
            const unsigned og = xb_add(&bar[XB_TOP], 1u);
            const unsigned tg = og / nx;
            if (og + 1u == (tg + 1u) * nx) xb_add(&bar[XB_TOPGEN], 1u);
            else XB_SPIN(xb_ld(&bar[XB_TOPGEN]) == tg, bar);
            __builtin_amdgcn_fence(__ATOMIC_ACQUIRE, "agent");
            xb_add(&bar[XB_XGEN(b.x)], 1u);
            asm volatile("s_waitcnt vmcnt(0)" ::: "memory");
        } else {
            XB_SPIN(xb_ld(&bar[XB_XGEN(b.x)]) == gen, bar);
            __builtin_amdgcn_fence(__ATOMIC_ACQUIRE, "agent");
            asm volatile("s_waitcnt vmcnt(0)" ::: "memory");
        }
    }
    __syncthreads();
}


struct Args {
    const float* x; const float* c; const int* pos; const float* w_in; const float* w_out; const float* dlam; const float* dsub; const float* w_ada; const float* b_ada;
    const float* g_attn; const float* g_ffn; const float* wg; const float* wu; const float* wd; const float* w_router; const float* eg; const float* eu; const float* ed; const float* g_final;
    float* out; unsigned char* ws; int ph_lo, ph_hi;
};

__device__ __forceinline__ unsigned pk_fp8x4(float a, float b, float c, float d) { unsigned w = 0u; w = __builtin_amdgcn_cvt_pk_fp8_f32(a, b, w, false); w = __builtin_amdgcn_cvt_pk_fp8_f32(c, d, w, true); return w; }
constexpr float F8_WSCALE = 64.f, F8_HSCALE = 4.f, F8_ASCALE = 4.f;
template <int MODE, bool F8>
__device__ __forceinline__ void tr_tile(const float* __restrict__ s0, const float* __restrict__ s1, int N, int K, void* __restrict__ dst, int p0, int k0, LAS float* scr, int tid) {
    {
        const int pl = tid & 63, p = p0 + pl, kk = tid >> 6;
        const float* src = s0; int col;
        if (MODE == 0) col = p;
        else if (MODE == 1) col = p < 832 ? p : (p < 2752 ? p + 4 : (p < 2756 ? p - 2752 + 832 : -1));
        else { col = 128 * (p >> 8) + (p & 127); if ((p >> 7) & 1) src = s1; }
        float v[32];
#pragma unroll
        for (int j = 0; j < 32; ++j) v[j] = (col >= 0) ? src[(size_t)(k0 + kk + 8 * j) * N + col] : 0.f;
#pragma unroll
        for (int j = 0; j < 32; ++j) scr[(kk + 8 * j) * 65 + pl] = v[j];
    }
    __syncthreads();
    {
        const int kc = tid & 31;
#pragma unroll
        for (int pass = 0; pass < 4; ++pass) {
            const int p = (tid >> 5) + 16 * pass;
            const LAS float* q = scr + (8 * kc) * 65 + p;
            if (F8) { u32x2 o; o.x = pk_fp8x4(q[0] * F8_WSCALE, q[65] * F8_WSCALE, q[130] * F8_WSCALE, q[195] * F8_WSCALE); o.y = pk_fp8x4(q[260] * F8_WSCALE, q[325] * F8_WSCALE, q[390] * F8_WSCALE, q[455] * F8_WSCALE);
                *(u32x2*)((unsigned char*)dst + (size_t)(p0 + p) * K + k0 + 8 * kc) = o; }
            else { u32x4 o; o.x = pk2(q[0], q[65]); o.y = pk2(q[130], q[195]); o.z = pk2(q[260], q[325]); o.w = pk2(q[390], q[455]);
                *(u32x4*)((bf16*)dst + (size_t)(p0 + p) * K + k0 + 8 * kc) = o; }
        }
    }
    __syncthreads();
}
struct TrItem { const float* s0; const float* s1; void* dst; int N, K, p0, k0, mode, f8; };
__device__ __forceinline__ void tr_load(const TrItem& I, float (&v)[32], int tid) {
    const int pl = tid & 63, p = I.p0 + pl, kk = tid >> 6;
    const float* src = I.s0; int col;
    if (I.mode == 0) col = p;
    else if (I.mode == 1) col = p < 832 ? p : (p < 2752 ? p + 4 : (p < 2756 ? p - 2752 + 832 : -1));
    else { col = 128 * (p >> 8) + (p & 127); if ((p >> 7) & 1) src = I.s1; }
    const float* sp = src + (size_t)(I.k0 + kk) * I.N + (col >= 0 ? col : 0);
    const size_t st = (size_t)8 * I.N;
#pragma unroll
    for (int j = 0; j < 32; ++j) v[j] = sp[j * st];
}
__device__ __forceinline__ void tr_lds_write(const TrItem& I, const float (&v)[32], LAS float* scr, int tid) {
    const int pl = tid & 63, kk = tid >> 6;
    const bool pad = I.mode == 1 && (I.p0 + pl) >= 2756;
#pragma unroll
    for (int j = 0; j < 32; ++j) scr[(kk + 8 * j) * 65 + pl] = pad ? 0.f : v[j];
}
__device__ __forceinline__ void tr_store(const TrItem& I, const LAS float* scr, int tid) {
    const int kc = tid & 31;
#pragma unroll
    for (int pass = 0; pass < 4; ++pass) {
        const int p = (tid >> 5) + 16 * pass;
        const LAS float* q = scr + (8 * kc) * 65 + p;
        if (I.f8) { u32x2 o; o.x = pk_fp8x4(q[0] * F8_WSCALE, q[65] * F8_WSCALE, q[130] * F8_WSCALE, q[195] * F8_WSCALE); o.y = pk_fp8x4(q[260] * F8_WSCALE, q[325] * F8_WSCALE, q[390] * F8_WSCALE, q[455] * F8_WSCALE);
            *(u32x2*)((unsigned char*)I.dst + (size_t)(I.p0 + p) * I.K + I.k0 + 8 * kc) = o; }
        else { u32x4 o; o.x = pk2(q[0], q[65]); o.y = pk2(q[130], q[195]); o.z = pk2(q[260], q[325]); o.w = pk2(q[390], q[455]);
            *(u32x4*)((bf16*)I.dst + (size_t)(I.p0 + p) * I.K + I.k0 + 8 * kc) = o; }
    }
}
typedef const __attribute__((address_space(4))) struct Args* ArgsP;
__device__ __forceinline__ void p0_prologue(ArgsP AP, LAS unsigned char* lds, int wg, int G, int tid) {
    unsigned char* ws = AP->ws;
    LAS float* scr = (LAS float*)lds;
    constexpr int I_IN = 44 * 4, I_OUT = 16 * 4, I_GU = 88 * 4, I_DN = 16 * 11;
    constexpr int N_IN = 4 * I_IN, N_OUT = 4 * I_OUT, N_GU = 2 * I_GU, N_DN = 2 * I_DN, N_EGU = 16 * I_GU, N_EDN = 16 * I_DN;
    constexpr int NITEMS = N_IN + N_OUT + N_GU + N_DN + N_EGU + N_EDN;
    {
        auto decode = [&](int it, TrItem& I) {
            int r = it;
            if (r < N_IN) { const int l = r / I_IN, q = r % I_IN; I = TrItem{AP->w_in + (size_t)l * DM * DIN, nullptr, ws + WS_WIN + l * SZ_WIN, DIN, DM, (q / 4) * 64, (q % 4) * 256, 1, 0}; return; } r -= N_IN;
            if (r < N_OUT) { const int l = r / I_OUT, q = r % I_OUT; I = TrItem{AP->w_out + (size_t)l * DM * DM, nullptr, ws + WS_WOUT + l * SZ_WOUT, DM, DM, (q / 4) * 64, (q % 4) * 256, 0, 0}; return; } r -= N_OUT;
            if (r < N_GU) { const int l = r / I_GU, q = r % I_GU; I = TrItem{AP->wg + (size_t)l * DM * DFF, AP->wu + (size_t)l * DM * DFF, ws + WS_WGU + l * SZ_WGU8, DFF, DM, (q / 4) * 64, (q % 4) * 256, 2, 1}; return; } r -= N_GU;
            if (r < N_DN) { const int l = r / I_DN, q = r % I_DN; I = TrItem{AP->wd + (size_t)l * DFF * DM, nullptr, ws + WS_WDN + l * SZ_WDN8, DM, DFF, (q / 11) * 64, (q % 11) * 256, 0, 1}; return; } r -= N_DN;
            if (r < N_EGU) { const int l = r / I_GU, q = r % I_GU; I = TrItem{AP->eg + (size_t)l * DM * DFF, AP->eu + (size_t)l * DM * DFF, ws + WS_EGU + l * SZ_WGU8, DFF, DM, (q / 4) * 64, (q % 4) * 256, 2, 1}; return; } r -= N_EGU;
            { const int l = r / I_DN, q = r % I_DN; I = TrItem{AP->ed + (size_t)l * DFF * DM, nullptr, ws + WS_EDN + l * SZ_WDN8, DM, DFF, (q / 11) * 64, (q % 11) * 256, 0, 1}; }
        };
        TrItem ia, ib; float va[32], vb[32];
        int it = wg;
        if (it < NITEMS) { decode(it, ia); tr_load(ia, va, tid); }
        if (it + G < NITEMS) { decode(it + G, ib); tr_load(ib, vb, tid); }
        while (it < NITEMS) {
            {   TrItem cur = ia;
                tr_lds_write(cur, va, scr, tid);
                asm volatile("s_waitcnt lgkmcnt(0)" ::: "memory"); __builtin_amdgcn_s_barrier(); asm volatile("" ::: "memory");
                if (it + 2 * G < NITEMS) { decode(it + 2 * G, ia); tr_load(ia, va, tid); }
                tr_store(cur, scr, tid);
                asm volatile("s_waitcnt lgkmcnt(0)" ::: "memory"); __builtin_amdgcn_s_barrier(); asm volatile("" ::: "memory");
            }
            it += G;
            if (it >= NITEMS) break;
            {   TrItem cur = ib;
                tr_lds_write(cur, vb, scr, tid);
                asm volatile("s_waitcnt lgkmcnt(0)" ::: "memory"); __builtin_amdgcn_s_barrier(); asm volatile("" ::: "memory");
                if (it + 2 * G < NITEMS) { decode(it + 2 * G, ib); tr_load(ib, vb, tid); }
                tr_store(cur, scr, tid);
                asm volatile("s_waitcnt lgkmcnt(0)" ::: "memory"); __builtin_amdgcn_s_barrier(); asm volatile("" ::: "memory");
            }
            it += G;
        }
        __syncthreads();
    }
    {
        LAS float* cact = (LAS float*)lds;
        bool have = false;
        for (int it = wg; it < 4 * 48; it += G) {
            if (!have) { for (int i = tid; i < NB * DM; i += NTHR) { const float v = AP->c[i]; cact[i] = v / (1.f + __expf(-v)); } have = true; __syncthreads(); }
            const int l = it / 48, j0 = (it % 48) * 128, cg = tid & 31, ks = tid >> 5;
            const float* w = AP->w_ada + (size_t)l * DM * MODW + j0 + 4 * cg;
            f32x4 acc[8];
#pragma unroll
            for (int b = 0; b < 8; ++b) acc[b] = (f32x4){0.f, 0.f, 0.f, 0.f};
            for (int k0 = ks * 64; k0 < ks * 64 + 64; k0 += 8) {
                f32x4 wv[8];
#pragma unroll
                for (int i = 0; i < 8; ++i) wv[i] = *(const f32x4*)(w + (size_t)(k0 + i) * MODW);
#pragma unroll
                for (int i = 0; i < 8; ++i)
#pragma unroll
                    for (int b = 0; b < 8; ++b) acc[b] += wv[i] * cact[b * DM + k0 + i];
            }
            LAS f32x4* red4 = (LAS f32x4*)(lds + 32768);
#pragma unroll
            for (int b = 0; b < 8; ++b) red4[(ks * 8 + b) * 32 + cg] = acc[b];
            __syncthreads();
            if (tid < 256) {
                const int b = tid >> 5, c = tid & 31;
                f32x4 sum = red4[b * 32 + c];
#pragma unroll
                for (int q = 1; q < 16; ++q) sum += red4[(q * 8 + b) * 32 + c];
                float* mod = (float*)(ws + WS_MOD) + (size_t)l * NB * MODW;
                const f32x4 bias = *(const f32x4*)(AP->b_ada + (size_t)l * MODW + j0 + 4 * c);
                *(f32x4*)(mod + (size_t)b * MODW + j0 + 4 * c) = sum + bias;
            }
            __syncthreads();
        }
    }
    { float* wrt = (float*)(ws + WS_WRT);
      for (int i = wg * NTHR + tid; i < 2 * NE * DM; i += G * NTHR) { const int j = i / (NE * DM), e = (i / DM) % NE, c = i % DM; wrt[i] = AP->w_router[((size_t)j * DM + c) * NE + e]; } }
    {
        float* rope = (float*)(ws + WS_ROPE);
        for (int m = wg * NTHR + tid; m < T; m += G * NTHR) {
            const float p = (float)AP->pos[m];
            float* r = rope + (size_t)m * 24;
            const float inv64[8] = {1.0f, 0.193922758102417f, 0.03760603070259094f, 0.00729266507551074f, 0.001414213445968926f, 0.00027424818836152554f, 5.318296462064609e-05f, 1.0313385246263351e-05f};
            const float inv32[4] = {1.0f, 0.03760603070259094f, 0.001414213445968926f, 5.318296462064609e-05f};
#pragma unroll
            for (int i = 0; i < 8; ++i) { const float a = p * inv64[i]; r[i] = cosf(a); r[8 + i] = sinf(a); }
#pragma unroll
            for (int i = 0; i < 4; ++i) { const float a = p * inv32[i]; r[16 + i] = cosf(a); r[20 + i] = sinf(a); }
        }
    }
}

__device__ __forceinline__ void bias_items(ArgsP AP, unsigned char* ws, LAS unsigned char* lds, int wg, int G, int tid) {
    LAS float* shv = (LAS float*)lds;
    const float* mod = (const float*)(ws + WS_MOD);
    for (int it = wg; it < 44 + 88; it += G) {
        const bool isP = it < 44;
        const int r = isP ? it : it - 44, li = isP ? r / 22 : r / 44, c0 = (isP ? r % 22 : r % 44) * 128;
        const int l = isP ? 2 * li + 1 : 2 * li;
        const float* shsrc = mod + (size_t)l * NB * MODW + (isP ? 0 : 3 * DM);
        for (int i = tid; i < NB * DM; i += NTHR) shv[i] = shsrc[(size_t)(i >> 10) * MODW + (i & 1023)];
        __syncthreads();
        const int cg = tid & 31, ks = tid >> 5, p = c0 + 4 * cg;
        const float* w; size_t pitch; bool valid = true;
        if (isP) { const int sc = p < 832 ? p : (p < 2752 ? p + 4 : (p < 2756 ? p - 2752 + 832 : -1)); valid = sc >= 0; w = AP->w_in + (size_t)l * DM * DIN + (valid ? sc : 0); pitch = DIN; }
        else { const int f = 4 * (p >> 3); w = (((p >> 2) & 1) ? AP->wu : AP->wg) + (size_t)li * DM * DFF + f; pitch = DFF; }
        f32x4 acc[8];
#pragma unroll
        for (int b = 0; b < 8; ++b) acc[b] = (f32x4){0.f, 0.f, 0.f, 0.f};
        for (int k0 = ks * 64; k0 < ks * 64 + 64; k0 += 8) {
            f32x4 wv[8];
#pragma unroll
            for (int i = 0; i < 8; ++i) wv[i] = valid ? *(const f32x4*)(w + (size_t)(k0 + i) * pitch) : (f32x4){0.f, 0.f, 0.f, 0.f};
#pragma unroll
            for (int i = 0; i < 8; ++i)
#pragma unroll
                for (int b = 0; b < 8; ++b) acc[b] += wv[i] * shv[b * DM + k0 + i];
        }
        LAS f32x4* red4 = (LAS f32x4*)(lds + 32768);
#pragma unroll
        for (int b = 0; b < 8; ++b) red4[(ks * 8 + b) * 32 + cg] = acc[b];
        __syncthreads();
        if (tid < 256) {
            const int b = tid >> 5, c = tid & 31;
            f32x4 sum = red4[b * 32 + c];
#pragma unroll
            for (int q = 1; q < 16; ++q) sum += red4[(q * 8 + b) * 32 + c];
            float* out = isP ? (float*)(ws + WS_BIASP) + (size_t)li * NB * NP : (float*)(ws + WS_BIASU) + (size_t)li * NB * 2 * DFF;
            const int N = isP ? NP : 2 * DFF;
            *(f32x4*)(out + (size_t)b * N + c0 + 4 * c) = sum;
        }
        __syncthreads();
    }
}

constexpr int CW_PANEL = 13312;
constexpr int CW_PANEL2 = CW_PANEL + 2048;
constexpr int CW_MOECNT = 12288;
__device__ __forceinline__ int moe_tables(const unsigned* gcnt, LAS int* tb  , LAS int* cn  , int tid) {
    if (tid == 0) { int acc = 0;
        for (int e = 0; e < 8; ++e) { const int c = (int)__hip_atomic_load(gcnt + e, __ATOMIC_RELAXED, __HIP_MEMORY_SCOPE_AGENT); cn[e] = c; tb[e] = acc; acc += (c + 255) >> 8; }
        tb[8] = acc; }
    __syncthreads();
    return __builtin_amdgcn_readfirstlane(tb[8]);
}
__device__ __forceinline__ int moe_expert_of_tile(const LAS int* tb, int tile) {
    int e = 0;
#pragma unroll
    for (int k = 1; k < 8; ++k) e += (tile >= tb[k]) ? 1 : 0;
    return e;
}
__device__ __forceinline__ f32x4 bf4_to_f32(unsigned long long w) { return (f32x4){__builtin_bit_cast(float, (unsigned)w << 16), __builtin_bit_cast(float, (unsigned)w & 0xffff0000u), __builtin_bit_cast(float, (unsigned)(w >> 32) << 16), __builtin_bit_cast(float, (unsigned)(w >> 32) & 0xffff0000u)}; }
__device__ __forceinline__ void bf8_to_f32(u32x4 w, f32x4& lo, f32x4& hi) { lo = (f32x4){bflo(w.x), bfhi(w.x), bflo(w.y), bfhi(w.y)}; hi = (f32x4){bflo(w.z), bfhi(w.z), bflo(w.w), bfhi(w.w)}; }
__device__ __forceinline__ u32x4 f32_to_bf8(f32x4 lo, f32x4 hi) { u32x4 w; w.x = pk2(lo.x, lo.y); w.y = pk2(lo.z, lo.w); w.z = pk2(hi.x, hi.y); w.w = pk2(hi.z, hi.w); return w; }
template <bool COMBINE, bool FINAL, bool OUT8 = false, bool XBF = true>
__device__ __forceinline__ void phase_norm(const void* xin, bf16* xout, const float* g, const float* mod_l, int off_sh, int off_sc, bf16* H, float* out,
                                           const bf16* R, const int* ENTI, const float* ENTW, const float* gate_prev, const LAS int* tb, int gw, int ngw, int lane) {
    const int rpw = T / ngw, m_lo = gw * rpw, m_hi = m_lo + rpw;
    const int b = m_lo >> 11;
    f32x4 gsv[2][2], shv4[2][2], gpv[2][2];
#pragma unroll
    for (int c = 0; c < 2; ++c)
#pragma unroll
        for (int n = 0; n < 2; ++n) { const int col = 8 * lane + 512 * c + 4 * n;
            if (FINAL) gsv[c][n] = *(const f32x4*)(g + col);
            else { gsv[c][n] = *(const f32x4*)(g + col) * (*(const f32x4*)(mod_l + (size_t)b * MODW + off_sc + col) + 1.f); shv4[c][n] = *(const f32x4*)(mod_l + (size_t)b * MODW + off_sh + col); }
            if (COMBINE) gpv[c][n] = *(const f32x4*)(gate_prev + (size_t)b * MODW + col); }
    f32x4 vn[2][2]; u32x4 an[2], cn[2]; float wn0 = 0.f, wn1 = 0.f;
#define PN_LOAD(mm) do { \
        if (XBF) { const u32x4* xr_ = (const u32x4*)((const bf16*)xin + (size_t)(mm) * DM) + lane; _Pragma("unroll") for (int c = 0; c < 2; ++c) bf8_to_f32(xr_[64 * c], vn[c][0], vn[c][1]); } \
        else { const f32x4* xr_ = (const f32x4*)((const float*)xin + (size_t)(mm) * DM) + 2 * lane; _Pragma("unroll") for (int c = 0; c < 2; ++c) { vn[c][0] = xr_[128 * c]; vn[c][1] = xr_[128 * c + 1]; } } \
        if (COMBINE) { const int vz_ = vzero(); \
            const int e0_ = ENTI[(size_t)(mm) * 4 + vz_], p0_ = ENTI[(size_t)(mm) * 4 + 1 + vz_], e1_ = ENTI[(size_t)(mm) * 4 + 2 + vz_], p1_ = ENTI[(size_t)(mm) * 4 + 3 + vz_]; \
            wn0 = ENTW[(size_t)(mm) * 2 + vz_]; wn1 = ENTW[(size_t)(mm) * 2 + 1 + vz_]; \
            const size_t r0_ = (size_t)(256 * tb[e0_] + p0_), r1_ = (size_t)(256 * tb[e1_] + p1_); \
            const u32x4* q0_ = (const u32x4*)(R + r0_ * DM) + lane; const u32x4* q1_ = (const u32x4*)(R + r1_ * DM) + lane; \
            _Pragma("unroll") for (int c = 0; c < 2; ++c) { an[c] = q0_[64 * c]; cn[c] = q1_[64 * c]; } } } while (0)
    PN_LOAD(m_lo);
    for (int m = m_lo; m < m_hi; ++m) {
        f32x4 v[2][2]; u32x4 a2[2], c2[2]; const float w0 = wn0, w1 = wn1; float ss = 0.f;
#pragma unroll
        for (int c = 0; c < 2; ++c) { v[c][0] = vn[c][0]; v[c][1] = vn[c][1]; if (COMBINE) { a2[c] = an[c]; c2[c] = cn[c]; } }
        if (m + 1 < m_hi) PN_LOAD(m + 1);
        if (COMBINE) {
            u32x4* xo = (u32x4*)(xout + (size_t)m * DM) + lane;
#pragma unroll
            for (int c = 0; c < 2; ++c) {
                f32x4 al, ah, cl, ch; bf8_to_f32(a2[c], al, ah); bf8_to_f32(c2[c], cl, ch);
                v[c][0] = v[c][0] + gpv[c][0] * (al * w0 + cl * w1);
                v[c][1] = v[c][1] + gpv[c][1] * (ah * w0 + ch * w1);
                if (!FINAL) xo[64 * c] = f32_to_bf8(v[c][0], v[c][1]);
            }
        }
#pragma unroll
        for (int c = 0; c < 2; ++c)
#pragma unroll
            for (int n = 0; n < 2; ++n) ss += (v[c][n].x * v[c][n].x + v[c][n].y * v[c][n].y) + (v[c][n].z * v[c][n].z + v[c][n].w * v[c][n].w);
        const float rstd = 1.f / sqrtf(wave_sum(ss) * (1.f / DM) + 1e-6f);
        if (FINAL) {
            f32x4* o = (f32x4*)(out + (size_t)m * DM) + 2 * lane;
#pragma unroll
            for (int c = 0; c < 2; ++c) { o[128 * c] = (v[c][0] * rstd) * gsv[c][0]; o[128 * c + 1] = (v[c][1] * rstd) * gsv[c][1]; }
        } else {
#pragma unroll
            for (int c = 0; c < 2; ++c) {
                const f32x4 h0 = (v[c][0] * rstd) * gsv[c][0] + shv4[c][0], h1 = (v[c][1] * rstd) * gsv[c][1] + shv4[c][1];
                if (OUT8) *((unsigned long long*)((unsigned char*)H + (size_t)m * DM) + lane + 64 * c) =
                    (unsigned long long)pk_fp8x4(h0.x * F8_HSCALE, h0.y * F8_HSCALE, h0.z * F8_HSCALE, h0.w * F8_HSCALE) | ((unsigned long long)pk_fp8x4(h1.x * F8_HSCALE, h1.y * F8_HSCALE, h1.z * F8_HSCALE, h1.w * F8_HSCALE) << 32);
                else *((u32x4*)(H + (size_t)m * DM) + lane + 64 * c) = f32_to_bf8(h0, h1);
            }
        }
    }
#undef PN_LOAD
}
__device__ __forceinline__ void phase_norm_route(const bf16* xin, const float* g, const float* mod_l, int off_sh, int off_sc, bf16* H, const float* wr, int* LIST, int* ENTI, float* ENTW, unsigned* gcnt,
                                                 LAS unsigned char* lds, int wg, int G, int tid, int lane, int wave) {
    LAS int* le = (LAS int*)lds;
    LAS int* lp = le + 128;
    LAS float* lw = (LAS float*)(lp + 128);
    LAS unsigned* lcnt = (LAS unsigned*)(lw + 128);
    LAS unsigned* lbase = lcnt + 8;
    for (int chunk = wg; chunk < T / 64; chunk += G) {
        if (tid < 8) lcnt[tid] = 0u;
        __syncthreads();
        f32x4 wra[16], wrb[16];
#pragma unroll
        for (int c = 0; c < 2; ++c)
#pragma unroll
            for (int i = 0; i < 8; ++i) { const int col = 8 * lane + 512 * c + i; wra[8 * c + i] = *(const f32x4*)(wr + (size_t)col * 8); wrb[8 * c + i] = *(const f32x4*)(wr + (size_t)col * 8 + 4); }
        f32x4 gsv[2][2], shv4[2][2];
        { const int b0 = (chunk * 64) >> 11;
#pragma unroll
          for (int c = 0; c < 2; ++c)
#pragma unroll
            for (int n = 0; n < 2; ++n) { const int col = 8 * lane + 512 * c + 4 * n; gsv[c][n] = *(const f32x4*)(g + col) * (*(const f32x4*)(mod_l + (size_t)b0 * MODW + off_sc + col) + 1.f); shv4[c][n] = *(const f32x4*)(mod_l + (size_t)b0 * MODW + off_sh + col); } }
        for (int rr = 0; rr < 8; ++rr) {
            const int rl = wave * 8 + rr, m = chunk * 64 + rl;
            const u32x4* xr = (const u32x4*)(xin + (size_t)m * DM) + lane;
            f32x4 v[2][2]; float ss = 0.f;
#pragma unroll
            for (int c = 0; c < 2; ++c) { bf8_to_f32(xr[64 * c], v[c][0], v[c][1]);
#pragma unroll
                for (int n = 0; n < 2; ++n) ss += (v[c][n].x * v[c][n].x + v[c][n].y * v[c][n].y) + (v[c][n].z * v[c][n].z + v[c][n].w * v[c][n].w); }
            const float rstd = 1.f / sqrtf(wave_sum(ss) * (1.f / DM) + 1e-6f);
            float pe[8];
#pragma unroll
            for (int e = 0; e < 8; ++e) pe[e] = 0.f;
#pragma unroll
            for (int c = 0; c < 2; ++c) {
                const f32x4 h0 = (v[c][0] * rstd) * gsv[c][0] + shv4[c][0], h1 = (v[c][1] * rstd) * gsv[c][1] + shv4[c][1];
                *((unsigned long long*)((unsigned char*)H + (size_t)m * DM) + lane + 64 * c) =
                    (unsigned long long)pk_fp8x4(h0.x * F8_HSCALE, h0.y * F8_HSCALE, h0.z * F8_HSCALE, h0.w * F8_HSCALE) | ((unsigned long long)pk_fp8x4(h1.x * F8_HSCALE, h1.y * F8_HSCALE, h1.z * F8_HSCALE, h1.w * F8_HSCALE) << 32);
                const float hv[8] = {h0.x, h0.y, h0.z, h0.w, h1.x, h1.y, h1.z, h1.w};
#pragma unroll
                for (int i = 0; i < 8; ++i) { const f32x4 w0 = wra[8 * c + i], w1 = wrb[8 * c + i];
                    pe[0] += hv[i] * w0.x; pe[1] += hv[i] * w0.y; pe[2] += hv[i] * w0.z; pe[3] += hv[i] * w0.w; pe[4] += hv[i] * w1.x; pe[5] += hv[i] * w1.y; pe[6] += hv[i] * w1.z; pe[7] += hv[i] * w1.w; }
            }
            {
                const bool b5 = lane & 32, b4 = lane & 16, b3 = lane & 8;
                float k0 = b5 ? pe[4] : pe[0], k1 = b5 ? pe[5] : pe[1], k2 = b5 ? pe[6] : pe[2], k3 = b5 ? pe[7] : pe[3];
                k0 += __shfl_xor(b5 ? pe[0] : pe[4], 32); k1 += __shfl_xor(b5 ? pe[1] : pe[5], 32); k2 += __shfl_xor(b5 ? pe[2] : pe[6], 32); k3 += __shfl_xor(b5 ? pe[3] : pe[7], 32);
                float m0 = b4 ? k2 : k0, m1 = b4 ? k3 : k1;
                m0 += __shfl_xor(b4 ? k0 : k2, 16); m1 += __shfl_xor(b4 ? k1 : k3, 16);
                float r0 = b3 ? m1 : m0;
                r0 += __shfl_xor(b3 ? m0 : m1, 8);
                r0 += __shfl_xor(r0, 4); r0 += __shfl_xor(r0, 2); r0 += __shfl_xor(r0, 1);
#pragma unroll
                for (int e = 0; e < 8; ++e) pe[e] = __builtin_bit_cast(float, __builtin_amdgcn_readlane(__builtin_bit_cast(int, r0), 8 * e));
            }
            int i0 = 0; float v0 = pe[0];
#pragma unroll
            for (int e = 1; e < 8; ++e) if (pe[e] > v0) { v0 = pe[e]; i0 = e; }
            int i1 = -1; float v1 = -INFINITY;
#pragma unroll
            for (int e = 0; e < 8; ++e) if (e != i0 && pe[e] > v1) { v1 = pe[e]; i1 = e; }
            const float e1 = __expf(v1 - v0), w0 = 1.f / (1.f + e1), w1 = e1 / (1.f + e1);
            if (lane == 0) {
                le[2 * rl] = i0; le[2 * rl + 1] = i1; lw[2 * rl] = w0; lw[2 * rl + 1] = w1;
                lp[2 * rl] = (int)__hip_atomic_fetch_add(lcnt + i0, 1u, __ATOMIC_RELAXED, __HIP_MEMORY_SCOPE_WORKGROUP);
                lp[2 * rl + 1] = (int)__hip_atomic_fetch_add(lcnt + i1, 1u, __ATOMIC_RELAXED, __HIP_MEMORY_SCOPE_WORKGROUP);
            }
        }
        __syncthreads();
        if (tid < 8) lbase[tid] = __hip_atomic_fetch_add(gcnt + tid, lcnt[tid], __ATOMIC_RELAXED, __HIP_MEMORY_SCOPE_AGENT);
        __syncthreads();
        if (tid < 128) {
            const int m = chunk * 64 + (tid >> 1), k = tid & 1, e = le[tid], p = (int)lbase[e] + lp[tid];
            LIST[(size_t)e * T + p] = m; ENTI[(size_t)m * 4 + 2 * k] = e; ENTI[(size_t)m * 4 + 2 * k + 1] = p; ENTW[(size_t)m * 2 + k] = lw[tid];
        }
        __syncthreads();
    }
}
__device__ __forceinline__ void phase_moe_gather(const bf16* H, bf16* HG, const int* LIST, const LAS int* tb, const LAS int* cn, int ntile, int gw, int ngw, int lane) {
    for (int row = gw; row < ntile * 256; row += ngw) {
        const int tile = row >> 8, e = moe_expert_of_tile(tb, tile), p = row - 256 * tb[e];
        u32x4 a = {0u, 0u, 0u, 0u};
        if (p < cn[e]) { const int src = LIST[(size_t)e * T + p + vzero()]; a = *((const u32x4*)((const unsigned char*)H + (size_t)src * DM) + lane); }
        *((u32x4*)((unsigned char*)HG + (size_t)row * DM) + lane) = a;
    }
}

__device__ __forceinline__ unsigned ord_key(float s) { if (s == 0.f) s = 0.f; const unsigned u = __builtin_bit_cast(unsigned, s); return (u & 0x80000000u) ? ~u : (u | 0x80000000u); }
__device__ __forceinline__ void idx_unit(int m, const bf16* __restrict__ PROJ, const float* __restrict__ WI, unsigned long long* MASKA, LAS unsigned char* lds, int tid, int lane, int wave) {
    const int b = m >> 11, t = m & 2047;
    unsigned long long* mrow = MASKA + (size_t)m * 32;
    if (t < 256) {
        if (tid < 32) { const int lo = tid * 64; mrow[tid] = (t >= lo + 63) ? ~0ull : (t < lo ? 0ull : ((2ull << (t - lo)) - 1ull)); }
        return;
    }
    LAS float* qs = (LAS float*)lds;
    LAS unsigned* cnt = (LAS unsigned*)(lds + 1024);
    LAS unsigned* cnt2 = (LAS unsigned*)(lds + 1024 + 64);
    LAS unsigned long long* tiebm = (LAS unsigned long long*)(lds + 2048);
    if (tid < 256) { const unsigned short q = PROJ[(size_t)m * NP + C_QI + tid]; qs[tid] = __builtin_bit_cast(float, (unsigned)q << 16); }
    const f32x4 wv = *(const f32x4*)(WI + (size_t)m * 4 + vzero());
    __syncthreads();
    unsigned u[4];
#pragma unroll
    for (int j = 0; j < 4; ++j) {
        const int s = tid + 512 * j;
        u[j] = 0u;
        if (s <= t) {
            const u32x4* kp = (const u32x4*)(PROJ + (size_t)(b * SEQ + s) * NP + C_KI);
            float a0 = 0.f, a1 = 0.f, a2 = 0.f, a3 = 0.f;
#pragma unroll
            for (int c = 0; c < 8; ++c) {
                const u32x4 kw = kp[c];
                float kf[8] = {bflo(kw.x), bfhi(kw.x), bflo(kw.y), bfhi(kw.y), bflo(kw.z), bfhi(kw.z), bflo(kw.w), bfhi(kw.w)};
#pragma unroll
                for (int i = 0; i < 8; ++i) { const int d = c * 8 + i; a0 += qs[d] * kf[i]; a1 += qs[64 + d] * kf[i]; a2 += qs[128 + d] * kf[i]; a3 += qs[192 + d] * kf[i]; }
            }
            const float sc = wv.x * fmaxf(a0, 0.f) + wv.y * fmaxf(a1, 0.f) + wv.z * fmaxf(a2, 0.f) + wv.w * fmaxf(a3, 0.f);
            u[j] = ord_key(sc);
        }
    }
    unsigned thr = 0u;
    for (int bit = 31; bit >= 0; --bit) {
        const unsigned cand = thr | (1u << bit);
        int c = 0;
#pragma unroll
        for (int j = 0; j < 4; ++j) c += __popcll(__ballot(u[j] >= cand));
        if (lane == 0) cnt[(bit & 1) * 8 + wave] = (unsigned)c;
        __syncthreads();
        unsigned tot = 0;
#pragma unroll
        for (int w = 0; w < 8; ++w) tot += cnt[(bit & 1) * 8 + w];
        if (tot >= 256u) thr = cand;
    }
    {
        int c = 0;
#pragma unroll
        for (int j = 0; j < 4; ++j) { c += __popcll(__ballot(u[j] > thr)); const unsigned long long bm = __ballot(u[j] == thr); if (lane == 0) tiebm[8 * j + wave] = bm; }
        if (lane == 0) cnt2[wave] = (unsigned)c;
        __syncthreads();
    }
    unsigned ngt = 0;
#pragma unroll
    for (int w = 0; w < 8; ++w) ngt += cnt2[w];
    const int need = 256 - (int)ngt;
#pragma unroll
    for (int j = 0; j < 4; ++j) {
        const int s = tid + 512 * j;
        bool sel = u[j] > thr;
        if (u[j] == thr) {
            const int wi = 8 * j + wave; int rank = 0;
            for (int w2 = 0; w2 < wi; ++w2) rank += __popcll(tiebm[w2]);
            rank += __popcll(tiebm[wi] & ((1ull << lane) - 1ull));
            sel = rank < need;
        }
        const unsigned long long bits = __ballot(sel && (s <= t));
        if (lane == 0) mrow[8 * j + wave] = bits;
    }
    __syncthreads();
}
typedef short ix_bf16x8 __attribute__((ext_vector_type(8)));
typedef float ix_f32x16 __attribute__((ext_vector_type(16)));
#define SEL_REDUCE2(xa, xb, cA, cB) \
        xa += __builtin_amdgcn_update_dpp(0, xa, 0xB1, 0xF, 0xF, true);  xb += __builtin_amdgcn_update_dpp(0, xb, 0xB1, 0xF, 0xF, true);       \
        xa += __builtin_amdgcn_update_dpp(0, xa, 0x4E, 0xF, 0xF, true);  xb += __builtin_amdgcn_update_dpp(0, xb, 0x4E, 0xF, 0xF, true);       \
        xa += __builtin_amdgcn_update_dpp(0, xa, 0x141, 0xF, 0xF, true); xb += __builtin_amdgcn_update_dpp(0, xb, 0x141, 0xF, 0xF, true);      \
        xa += __builtin_amdgcn_update_dpp(0, xa, 0x140, 0xF, 0xF, true); xb += __builtin_amdgcn_update_dpp(0, xb, 0x140, 0xF, 0xF, true);      \
        const int cA = __builtin_amdgcn_readlane(xa, 0) + __builtin_amdgcn_readlane(xa, 16) + __builtin_amdgcn_readlane(xa, 32) + __builtin_amdgcn_readlane(xa, 48); \
        const int cB = __builtin_amdgcn_readlane(xb, 0) + __builtin_amdgcn_readlane(xb, 16) + __builtin_amdgcn_readlane(xb, 32) + __builtin_amdgcn_readlane(xb, 48);
#define SEL_CNT4(cla, clb, candA, candB, a0, a1, a2, a3, b0, b1, b2, b3) do { unsigned long long tp; \
            asm volatile( \
                "v_cmp_le_u32_e32 vcc, %3, %5\n\tv_cmp_le_u32_e64 %2, %4, %9\n\tv_addc_co_u32_e32 %0, vcc, 0, %0, vcc\n\tv_addc_co_u32_e64 %1, %2, 0, %1, %2\n\t" \
                "v_cmp_le_u32_e32 vcc, %3, %6\n\tv_cmp_le_u32_e64 %2, %4, %10\n\tv_addc_co_u32_e32 %0, vcc, 0, %0, vcc\n\tv_addc_co_u32_e64 %1, %2, 0, %1, %2\n\t" \
                "v_cmp_le_u32_e32 vcc, %3, %7\n\tv_cmp_le_u32_e64 %2, %4, %11\n\tv_addc_co_u32_e32 %0, vcc, 0, %0, vcc\n\tv_addc_co_u32_e64 %1, %2, 0, %1, %2\n\t" \
                "v_cmp_le_u32_e32 vcc, %3, %8\n\tv_cmp_le_u32_e64 %2, %4, %12\n\tv_addc_co_u32_e32 %0, vcc, 0, %0, vcc\n\tv_addc_co_u32_e64 %1, %2, 0, %1, %2" \
                : "+v"(cla), "+v"(clb), "=&s"(tp) \
                : "s"(candA), "s"(candB), "v"(a0), "v"(a1), "v"(a2), "v"(a3), "v"(b0), "v"(b1), "v"(b2), "v"(b3) : "vcc"); } while (0)
template <int NQ4>
__device__ __forceinline__ void sel_search(const unsigned (&ua)[32], const unsigned (&ub)[32], unsigned& thrA_, unsigned& thrB_, int& cgeA_, int& cgeB_, LAS unsigned* la, LAS unsigned* lb, int lane) {
    unsigned thrA = 0u, thrB = 0u, upA = 0u, upB = 0u;
    int cgeA = 256 * NQ4, cgeB = 256 * NQ4, cabA = 0, cabB = 0; bool doneA = false, doneB = false, compact = false;
    int bit = 31;
#pragma unroll 1
    for (; bit >= 0 && !(doneA && doneB); --bit) {
        const unsigned candA = thrA | (1u << bit), candB = thrB | (1u << bit);
        unsigned cla = 0u, clb = 0u;
#pragma unroll
        for (int j0 = 0; j0 < 4 * NQ4; j0 += 4) SEL_CNT4(cla, clb, candA, candB, ua[j0], ua[j0 + 1], ua[j0 + 2], ua[j0 + 3], ub[j0], ub[j0 + 1], ub[j0 + 2], ub[j0 + 3]);
        int xa = (int)cla, xb = (int)clb;
        SEL_REDUCE2(xa, xb, cA, cB)
        if (!doneA) { if (cA >= 256) { thrA = candA; cgeA = cA; if (cA == 256) doneA = true; } else { upA = candA; cabA = cA; } }
        if (!doneB) { if (cB >= 256) { thrB = candB; cgeB = cB; if (cB == 256) doneB = true; } else { upB = candB; cabB = cB; } }
        if (NQ4 >= 3 && bit >= 6 && cgeA - cabA <= 256 && cgeB - cabB <= 256 && !(doneA && doneB)) { compact = true; --bit; break; }
    }
    if (NQ4 >= 3 && compact) {
        unsigned ca[4], cb[4];
        {
            const unsigned wA = upA - thrA, wB = upB - thrB;
#pragma unroll
            for (int k = 0; k < 4; ++k) { la[lane + 64 * k] = 0u; lb[lane + 64 * k] = 0u; }
            int baseA = 0, baseB = 0;
#pragma unroll
            for (int j = 0; j < 4 * NQ4; ++j) {
                const bool ipa = (ua[j] - thrA) < wA, ipb = (ub[j] - thrB) < wB;
                const unsigned long long ma = __ballot(ipa), mb = __ballot(ipb);
                const int pa = baseA + (int)__builtin_amdgcn_mbcnt_hi((unsigned)(ma >> 32), __builtin_amdgcn_mbcnt_lo((unsigned)ma, 0u));
                const int pb = baseB + (int)__builtin_amdgcn_mbcnt_hi((unsigned)(mb >> 32), __builtin_amdgcn_mbcnt_lo((unsigned)mb, 0u));
                if (ipa) la[pa] = ua[j];
                if (ipb) lb[pb] = ub[j];
                baseA += __popcll(ma); baseB += __popcll(mb);
            }
#pragma unroll
            for (int k = 0; k < 4; ++k) { ca[k] = la[lane + 64 * k]; cb[k] = lb[lane + 64 * k]; }
        }
#pragma unroll 1
        for (; bit >= 0 && !(doneA && doneB); --bit) {
            const unsigned candA = thrA | (1u << bit), candB = thrB | (1u << bit);
            unsigned cla = 0u, clb = 0u;
            SEL_CNT4(cla, clb, candA, candB, ca[0], ca[1], ca[2], ca[3], cb[0], cb[1], cb[2], cb[3]);
            int xa = (int)cla, xb = (int)clb;
            SEL_REDUCE2(xa, xb, cA0, cB0)
            const int cA = cA0 + cabA, cB = cB0 + cabB;
            if (!doneA && cA >= 256) { thrA = candA; cgeA = cA; if (cA == 256) doneA = true; }
            if (!doneB && cB >= 256) { thrB = candB; cgeB = cB; if (cB == 256) doneB = true; }
        }
    }
    thrA_ = thrA; thrB_ = thrB; cgeA_ = cgeA; cgeB_ = cgeB;
}
#undef SEL_CNT4
#undef SEL_REDUCE2
__device__ __forceinline__ void idx_unit16(int u16, const bf16* __restrict__ PROJ, const float* __restrict__ WI, unsigned long long* MASKA, LAS unsigned char* lds, int tid, int lane, int wave) {
    const int m0 = u16 * 16, b = m0 >> 11, t0 = m0 & 2047;
    if (t0 < 256) {
#pragma unroll
        for (int qq = 0; qq < 2; ++qq) { const int t = t0 + 2 * wave + qq; const int lo = lane * 64;
            if (lane < 32) MASKA[(size_t)(m0 + 2 * wave + qq) * 32 + lane] = (t >= lo + 63) ? ~0ull : (t < lo ? 0ull : ((2ull << (t - lo)) - 1ull)); }
        return;
    }
    LAS float* sc = (LAS float*)lds;
    const int r = lane & 31, h = lane >> 5;
    {
        ix_bf16x8 qa[2][4]; float wq[2][4][4];
#pragma unroll
        for (int rb = 0; rb < 2; ++rb) {
            const bf16* qp = PROJ + (size_t)(m0 + rb * 8 + (r >> 2)) * NP + C_QI + (r & 3) * 64 + 8 * h;
#pragma unroll
            for (int s = 0; s < 4; ++s) qa[rb][s] = *(const ix_bf16x8*)(qp + 16 * s);
#pragma unroll
            for (int g = 0; g < 4; ++g) { const f32x4 w = *(const f32x4*)(WI + (size_t)(m0 + rb * 8 + 2 * g + h) * 4);
                wq[rb][g][0] = w.x; wq[rb][g][1] = w.y; wq[rb][g][2] = w.z; wq[rb][g][3] = w.w; }
        }
        const int nkb = ((t0 + 15) >> 5) + 1;
        for (int kb0 = wave; kb0 < nkb; kb0 += 32) {
            ix_bf16x8 kf[4][4];
#pragma unroll
            for (int i = 0; i < 4; ++i) { const int kb = kb0 + 8 * i;
                if (kb < nkb) { const bf16* kp = PROJ + (size_t)(b * SEQ + kb * 32 + r) * NP + C_KI + 8 * h;
#pragma unroll
                    for (int s = 0; s < 4; ++s) kf[i][s] = *(const ix_bf16x8*)(kp + 16 * s); } }
#pragma unroll
            for (int i = 0; i < 4; ++i) { const int kb = kb0 + 8 * i;
                if (kb < nkb) { const int key = kb * 32 + r;
#pragma unroll
                    for (int rb = 0; rb < 2; ++rb) {
                        ix_f32x16 acc = {};
#pragma unroll
                        for (int s = 0; s < 4; ++s) acc = __builtin_amdgcn_mfma_f32_32x32x16_bf16(qa[rb][s], kf[i][s], acc, 0, 0, 0);
#pragma unroll
                        for (int g = 0; g < 4; ++g) {
                            const float v = wq[rb][g][0] * fmaxf(acc[4 * g], 0.f) + wq[rb][g][1] * fmaxf(acc[4 * g + 1], 0.f) + wq[rb][g][2] * fmaxf(acc[4 * g + 2], 0.f) + wq[rb][g][3] * fmaxf(acc[4 * g + 3], 0.f);
                            sc[(rb * 8 + 2 * g + h) * 2048 + key] = v;
                        }
                    } } }
        }
    }
    __syncthreads();
    {
        const int qlA = 2 * wave, qlB = qlA + 1, tA = t0 + qlA, tB = tA + 1;
        const int nj = (tB >> 6) + 1;
        unsigned ua[32], ub[32];
#pragma unroll
        for (int j = 0; j < 32; ++j) { ua[j] = 0u; ub[j] = 0u; }
#pragma unroll
        for (int j0 = 0; j0 < 32; j0 += 8) if (j0 < nj) {
#pragma unroll
            for (int k = 0; k < 8; ++k) { const int key = 64 * (j0 + k) + lane;
                const float va = sc[qlA * 2048 + (key < tA ? key : tA)], vb = sc[qlB * 2048 + (key < tB ? key : tB)];
                ua[j0 + k] = (key <= tA) ? ord_key(va) : 0u; ub[j0 + k] = (key <= tB) ? ord_key(vb) : 0u; }
        }
        unsigned thrA = 0u, thrB = 0u; int cgeA = 0, cgeB = 0;
        switch ((nj + 3) >> 2) {
            case 2: sel_search<2>(ua, ub, thrA, thrB, cgeA, cgeB, (LAS unsigned*)(sc + qlA * 2048), (LAS unsigned*)(sc + qlB * 2048), lane); break;
            case 3: sel_search<3>(ua, ub, thrA, thrB, cgeA, cgeB, (LAS unsigned*)(sc + qlA * 2048), (LAS unsigned*)(sc + qlB * 2048), lane); break;
            case 4: sel_search<4>(ua, ub, thrA, thrB, cgeA, cgeB, (LAS unsigned*)(sc + qlA * 2048), (LAS unsigned*)(sc + qlB * 2048), lane); break;
            case 5: sel_search<5>(ua, ub, thrA, thrB, cgeA, cgeB, (LAS unsigned*)(sc + qlA * 2048), (LAS unsigned*)(sc + qlB * 2048), lane); break;
            case 6: sel_search<6>(ua, ub, thrA, thrB, cgeA, cgeB, (LAS unsigned*)(sc + qlA * 2048), (LAS unsigned*)(sc + qlB * 2048), lane); break;
            case 7: sel_search<7>(ua, ub, thrA, thrB, cgeA, cgeB, (LAS unsigned*)(sc + qlA * 2048), (LAS unsigned*)(sc + qlB * 2048), lane); break;
            default: sel_search<8>(ua, ub, thrA, thrB, cgeA, cgeB, (LAS unsigned*)(sc + qlA * 2048), (LAS unsigned*)(sc + qlB * 2048), lane); break;
        }
#pragma unroll 1
        for (int qq = 0; qq < 2; ++qq) {
            const unsigned thr = qq ? thrB : thrA; const int cge = qq ? cgeB : cgeA, ql = qq ? qlB : qlA;
            unsigned long long myword = 0ull;
            if (cge == 256) {
#pragma unroll
                for (int j = 0; j < 32; ++j) { const unsigned uj = qq ? ub[j] : ua[j]; const unsigned long long word = __ballot(uj >= thr); if (lane == j) myword = word; }
            } else {
                int ngt = 0;
#pragma unroll
                for (int j = 0; j < 32; ++j) { const unsigned uj = qq ? ub[j] : ua[j]; ngt += __popcll(__ballot(uj > thr)); }
                const int need = 256 - ngt;
                int base = 0;
#pragma unroll
                for (int j = 0; j < 32; ++j) {
                    const unsigned uj = qq ? ub[j] : ua[j];
                    const unsigned long long tb = __ballot(uj == thr);
                    const int below = (int)__builtin_amdgcn_mbcnt_hi((unsigned)(tb >> 32), __builtin_amdgcn_mbcnt_lo((unsigned)tb, 0u));
                    const bool sel = (uj > thr) || (uj == thr && (base + below) < need);
                    const unsigned long long word = __ballot(sel);
                    if (lane == j) myword = word;
                    base += __popcll(tb);
                }
            }
            if (lane < 32) MASKA[(size_t)(m0 + ql) * 32 + lane] = myword;
        }
    }
    __syncthreads();
}
__device__ __forceinline__ void kmean_unit(int it, const bf16* __restrict__ PROJ, float* KMEAN, LAS unsigned char* lds, int tid) {
    const int b = it / 48, h = (it % 48) / 8, n = it % 8;
    LAS float* red = (LAS float*)lds;
    const int ch = tid & 7, rs = tid >> 3;
    const bf16* kp = PROJ + (size_t)(b * SEQ + n * 256 + rs) * NP + C_KC + h * 64 + 8 * ch;
    u32x4 w[4];
#pragma unroll
    for (int i = 0; i < 4; ++i) w[i] = *(const u32x4*)(kp + (size_t)(64 * i) * NP);
    f32x4 lo = {0.f, 0.f, 0.f, 0.f}, hi = lo;
#pragma unroll
    for (int i = 0; i < 4; ++i) { f32x4 l_, h_; bf8_to_f32(w[i], l_, h_); lo += l_; hi += h_; }
    *(LAS f32x4*)(red + rs * 64 + 8 * ch) = lo; *(LAS f32x4*)(red + rs * 64 + 8 * ch + 4) = hi;
    __syncthreads();
    if (tid < 64) { float a = 0.f;
#pragma unroll 16
        for (int p = 0; p < 64; ++p) a += red[p * 64 + tid];
        KMEAN[(size_t)it * 64 + tid] = a * (1.f / 256.f); }
    __syncthreads();
}

template <int DQ, int KIND>
__device__ __forceinline__ void attn_naive_task(int b, int qb, int qcol, int kcol, int vcol, const bf16* __restrict__ PROJ, const unsigned long long* __restrict__ MASKA, const float* __restrict__ kmean  ,
                                                bf16* yout  , float* dout  , int lane) {
    const int t = qb * 64 + lane; const size_t m = (size_t)b * SEQ + t; const int vz = vzero();
    float q[DQ], o[64];
    {
        const u32x4* qp = (const u32x4*)(PROJ + m * NP + qcol);
#pragma unroll
        for (int c = 0; c < DQ / 8; ++c) { const u32x4 w = qp[c]; q[8 * c] = bflo(w.x); q[8 * c + 1] = bfhi(w.x); q[8 * c + 2] = bflo(w.y); q[8 * c + 3] = bfhi(w.y); q[8 * c + 4] = bflo(w.z); q[8 * c + 5] = bfhi(w.z); q[8 * c + 6] = bflo(w.w); q[8 * c + 7] = bfhi(w.w); }
    }
#pragma unroll
    for (int d = 0; d < 64; ++d) o[d] = 0.f;
    float mx = -1e30f, l = 0.f;
    unsigned selb = 0u;
    if (KIND == 2) {
        const int npast = t >> 8;
        float gt[8];
#pragma unroll
        for (int n = 0; n < 8; ++n) { float a = 0.f;
#pragma unroll
            for (int d = 0; d < 64; ++d) a += q[d] * kmean[n * 64 + d + vz];
            asm volatile("" : "+v"(a) :: "memory"); gt[n] = a; }
#pragma unroll
        for (int n = 0; n < 8; ++n) { int rank = 0;
#pragma unroll
            for (int j = 0; j < 8; ++j) rank += (j < npast && (gt[j] > gt[n] || (gt[j] == gt[n] && j < n))) ? 1 : 0;
            if (n < npast && rank < 3) selb |= 1u << n; }
    }
    const unsigned long long* mrow = MASKA + m * 32;
    unsigned long long mword = 0ull;
    const int send = qb * 64 + 63;
    for (int s = 0; s <= send; ++s) {
        if (KIND == 0) { if ((s & 63) == 0) mword = mrow[s >> 6]; }
        bool valid = s <= t;
        if (KIND == 0) valid = valid && ((mword >> (s & 63)) & 1ull);
        if (KIND == 2) valid = valid && (((s >> 8) == (t >> 8)) || ((selb >> (s >> 8)) & 1u));
        if (!__any(valid)) continue;
        const bf16* krow = PROJ + ((size_t)b * SEQ + s) * NP + vz;
        float sc = 0.f;
        {
            const u32x4* kp = (const u32x4*)(krow + kcol);
#pragma unroll
            for (int c = 0; c < DQ / 8; ++c) { const u32x4 w = kp[c];
                sc += q[8 * c] * bflo(w.x) + q[8 * c + 1] * bfhi(w.x) + q[8 * c + 2] * bflo(w.y) + q[8 * c + 3] * bfhi(w.y) + q[8 * c + 4] * bflo(w.z) + q[8 * c + 5] * bfhi(w.z) + q[8 * c + 6] * bflo(w.w) + q[8 * c + 7] * bfhi(w.w); }
        }
        if (valid) {
            if (sc > mx) { const float corr = __builtin_amdgcn_exp2f(mx - sc); l *= corr;
#pragma unroll
                for (int d = 0; d < 64; ++d) o[d] *= corr;
                mx = sc; }
            const float p = __builtin_amdgcn_exp2f(sc - mx);
            l += p;
            const u32x4* vp = (const u32x4*)(krow + vcol);
#pragma unroll
            for (int c = 0; c < 8; ++c) { const u32x4 w = vp[c];
                o[8 * c] += p * bflo(w.x); o[8 * c + 1] += p * bfhi(w.x); o[8 * c + 2] += p * bflo(w.y); o[8 * c + 3] += p * bfhi(w.y); o[8 * c + 4] += p * bflo(w.z); o[8 * c + 5] += p * bfhi(w.z); o[8 * c + 6] += p * bflo(w.w); o[8 * c + 7] += p * bfhi(w.w); }
        }
    }
    const float rl = 1.f / l;
    if (KIND == 1) {
        f32x4* dp = (f32x4*)(dout + m * 512);
#pragma unroll
        for (int c = 0; c < 16; ++c) dp[c] = (f32x4){o[4 * c] * rl, o[4 * c + 1] * rl, o[4 * c + 2] * rl, o[4 * c + 3] * rl};
    } else {
        u32x4* yp = (u32x4*)(yout + m * DM);
#pragma unroll
        for (int c = 0; c < 8; ++c) { u32x4 w; w.x = pk2(o[8 * c] * rl, o[8 * c + 1] * rl); w.y = pk2(o[8 * c + 2] * rl, o[8 * c + 3] * rl); w.z = pk2(o[8 * c + 4] * rl, o[8 * c + 5] * rl); w.w = pk2(o[8 * c + 6] * rl, o[8 * c + 7] * rl); yp[c] = w; }
    }
}
__device__ __forceinline__ void phase_attn_naive(const bf16* PROJ, const unsigned long long* MASKA, const float* KMEAN, bf16* Y, float* DTMP, int gw, int ngw, int lane) {
    for (int id = gw; id < 32 * 160; id += ngw) {
        const int qb = 31 - id / 160, r = id % 160;
        if (r < 48) { const int b = r / 6, h = r % 6; attn_naive_task<64, 0>(b, qb, C_QA + h * 64, C_KA, C_VA, PROJ, MASKA, nullptr, Y + h * 64, nullptr, lane); }
        else if (r < 112) { const int r2 = r - 48, b = r2 / 8, hc = r2 % 8; attn_naive_task<32, 1>(b, qb, C_QB + hc * 32, C_KB + hc * 32, C_VB + (hc >> 1) * 64, PROJ, MASKA, nullptr, nullptr, DTMP + hc * 64, lane); }
        else { const int r2 = r - 112, b = r2 / 6, h = r2 % 6; attn_naive_task<64, 2>(b, qb, C_QC + h * 64, C_KC + h * 64, C_VC + h * 64, PROJ, MASKA, KMEAN + (size_t)(b * 6 + h) * 512, Y + 640 + h * 64, nullptr, lane); }
    }
}
__device__ __forceinline__ void phase_diff_combine(const float* DTMP, const float* dlam_l, const float* dsub_l, float lam_init, bf16* Y, int gw, int ngw, int lane) {
    float sa = 0.f, sb = 0.f;
    if (lane < 32) { sa = dlam_l[lane] * dlam_l[32 + lane]; sb = dlam_l[64 + lane] * dlam_l[96 + lane]; }
    const float lam = expf(wave_sum(sa)) - expf(wave_sum(sb)) + lam_init;
    const float gs = dsub_l[lane] * (1.f - lam_init);
    for (int m = gw; m < T; m += ngw) {
#pragma unroll
        for (int h = 0; h < 4; ++h) {
            const float o = DTMP[(size_t)m * 512 + (2 * h) * 64 + lane] - lam * DTMP[(size_t)m * 512 + (2 * h + 1) * 64 + lane];
            const float ss = wave_sum(o * o);
            const float y = o * (1.f / sqrtf(ss * (1.f / 64.f) + 1e-5f)) * gs;
            Y[(size_t)m * DM + 384 + h * 64 + lane] = (bf16)f2bf(y);
        }
    }
}

__device__ const unsigned short ATT_UNITS[1024] = {
    1080, 1081, 1082, 1083, 1208, 1209, 1210, 1211, 1336, 1337, 1338, 1339, 1464, 1465, 1466, 1467,
    1592, 1593, 1594, 1595, 1720, 1721, 1722, 1723, 1848, 1849, 1850, 1851, 1976, 1977, 1978, 1979,
    1072, 1073, 1074, 1075, 1200, 1201, 1202, 1203, 1328, 1329, 1330, 1331, 1456, 1457, 1458, 1459,
    1584, 1585, 1586, 1587, 1712, 1713, 1714, 1715, 1840, 1841, 1842, 1843, 1968, 1969, 1970, 1971,
    1064, 1065, 1066, 1067, 1192, 1193, 1194, 1195, 1320, 1321, 1322, 1323, 1448, 1449, 1450, 1451,
    1576, 1577, 1578, 1579, 1704, 1705, 1706, 1707, 1832, 1833, 1834, 1835, 1960, 1961, 1962, 1963,
    120, 121, 122, 248, 249, 250, 376, 377, 378, 504, 505, 506, 632, 633, 634, 760,
    761, 762, 888, 889, 890, 1016, 1017, 1018, 2104, 2105, 2106, 2107, 2108, 2109, 2232, 2233,
    2234, 2235, 2236, 2237, 2360, 2361, 2362, 2363, 2364, 2365, 2488, 2489, 2490, 2491, 2492, 2493,
    2616, 2617, 2618, 2619, 2620, 2621, 2744, 2745, 2746, 2747, 2748, 2749, 2872, 2873, 2874, 2875,
    2876, 2877, 3000, 3001, 3002, 3003, 3004, 3005, 112, 113, 114, 240, 241, 242, 368, 369,
    370, 496, 497, 498, 624, 625, 626, 752, 753, 754, 880, 881, 882, 1008, 1009, 1010,
    1056, 1057, 1058, 1059, 1184, 1185, 1186, 1187, 1312, 1313, 1314, 1315, 1440, 1441, 1442, 1443,
    1568, 1569, 1570, 1571, 1696, 1697, 1698, 1699, 1824, 1825, 1826, 1827, 1952, 1953, 1954, 1955,
    104, 105, 106, 232, 233, 234, 360, 361, 362, 488, 489, 490, 616, 617, 618, 744,
    745, 746, 872, 873, 874, 1000, 1001, 1002, 2096, 2097, 2098, 2099, 2100, 2101, 2224, 2225,
    2226, 2227, 2228, 2229, 2352, 2353, 2354, 2355, 2356, 2357, 2480, 2481, 2482, 2483, 2484, 2485,
    2608, 2609, 2610, 2611, 2612, 2613, 2736, 2737, 2738, 2739, 2740, 2741, 2864, 2865, 2866, 2867,
    2868, 2869, 2992, 2993, 2994, 2995, 2996, 2997, 96, 97, 98, 224, 225, 226, 352, 353,
    354, 480, 481, 482, 608, 609, 610, 736, 737, 738, 864, 865, 866, 992, 993, 994,
    88, 89, 90, 216, 217, 218, 344, 345, 346, 472, 473, 474, 600, 601, 602, 728,
    729, 730, 856, 857, 858, 984, 985, 986, 1048, 1049, 1050, 1051, 1176, 1177, 1178, 1179,
    1304, 1305, 1306, 1307, 1432, 1433, 1434, 1435, 1560, 1561, 1562, 1563, 1688, 1689, 1690, 1691,
    1816, 1817, 1818, 1819, 1944, 1945, 1946, 1947, 2088, 2089, 2090, 2091, 2092, 2093, 2216, 2217,
    2218, 2219, 2220, 2221, 2344, 2345, 2346, 2347, 2348, 2349, 2472, 2473, 2474, 2475, 2476, 2477,
    2600, 2601, 2602, 2603, 2604, 2605, 2728, 2729, 2730, 2731, 2732, 2733, 2856, 2857, 2858, 2859,
    2860, 2861, 2984, 2985, 2986, 2987, 2988, 2989, 80, 81, 82, 208, 209, 210, 336, 337,
    338, 464, 465, 466, 592, 593, 594, 720, 721, 722, 848, 849, 850, 976, 977, 978,
    72, 73, 74, 200, 201, 202, 328, 329, 330, 456, 457, 458, 584, 585, 586, 712,
    713, 714, 840, 841, 842, 968, 969, 970, 2080, 2081, 2082, 2083, 2084, 2085, 2208, 2209,
    2210, 2211, 2212, 2213, 2336, 2337, 2338, 2339, 2340, 2341, 2464, 2465, 2466, 2467, 2468, 2469,
    2592, 2593, 2594, 2595, 2596, 2597, 2720, 2721, 2722, 2723, 2724, 2725, 2848, 2849, 2850, 2851,
    2852, 2853, 2976, 2977, 2978, 2979, 2980, 2981, 64, 65, 66, 192, 193, 194, 320, 321,
    322, 448, 449, 450, 576, 577, 578, 704, 705, 706, 832, 833, 834, 960, 961, 962,
    1040, 1041, 1042, 1043, 1168, 1169, 1170, 1171, 1296, 1297, 1298, 1299, 1424, 1425, 1426, 1427,
    1552, 1553, 1554, 1555, 1680, 1681, 1682, 1683, 1808, 1809, 1810, 1811, 1936, 1937, 1938, 1939,
    56, 57, 58, 184, 185, 186, 312, 313, 314, 440, 441, 442, 568, 569, 570, 696,
    697, 698, 824, 825, 826, 952, 953, 954, 2072, 2073, 2074, 2075, 2076, 2077, 2200, 2201,
    2202, 2203, 2204, 2205, 2328, 2329, 2330, 2331, 2332, 2333, 2456, 2457, 2458, 2459, 2460, 2461,
    2584, 2585, 2586, 2587, 2588, 2589, 2712, 2713, 2714, 2715, 2716, 2717, 2840, 2841, 2842, 2843,
    2844, 2845, 2968, 2969, 2970, 2971, 2972, 2973, 48, 49, 50, 176, 177, 178, 304, 305,
    306, 432, 433, 434, 560, 561, 562, 688, 689, 690, 816, 817, 818, 944, 945, 946,
    40, 41, 42, 168, 169, 170, 296, 297, 298, 424, 425, 426, 552, 553, 554, 680,
    681, 682, 808, 809, 810, 936, 937, 938, 1032, 1033, 1034, 1035, 1160, 1161, 1162, 1163,
    1288, 1289, 1290, 1291, 1416, 1417, 1418, 1419, 1544, 1545, 1546, 1547, 1672, 1673, 1674, 1675,
    1800, 1801, 1802, 1803, 1928, 1929, 1930, 1931, 2064, 2065, 2066, 2067, 2068, 2069, 2192, 2193,
    2194, 2195, 2196, 2197, 2320, 2321, 2322, 2323, 2324, 2325, 2448, 2449, 2450, 2451, 2452, 2453,
    2576, 2577, 2578, 2579, 2580, 2581, 2704, 2705, 2706, 2707, 2708, 2709, 2832, 2833, 2834, 2835,
    2836, 2837, 2960, 2961, 2962, 2963, 2964, 2965, 32, 33, 34, 160, 161, 162, 288, 289,
    290, 416, 417, 418, 544, 545, 546, 672, 673, 674, 800, 801, 802, 928, 929, 930,
    24, 25, 26, 152, 153, 154, 280, 281, 282, 408, 409, 410, 536, 537, 538, 664,
    665, 666, 792, 793, 794, 920, 921, 922, 2056, 2057, 2058, 2059, 2060, 2061, 2184, 2185,
    2186, 2187, 2188, 2189, 2312, 2313, 2314, 2315, 2316, 2317, 2440, 2441, 2442, 2443, 2444, 2445,
    2568, 2569, 2570, 2571, 2572, 2573, 2696, 2697, 2698, 2699, 2700, 2701, 2824, 2825, 2826, 2827,
    2828, 2829, 2952, 2953, 2954, 2955, 2956, 2957, 16, 17, 18, 144, 145, 146, 272, 273,
    274, 400, 401, 402, 528, 529, 530, 656, 657, 658, 784, 785, 786, 912, 913, 914,
    1024, 1025, 1026, 1027, 1152, 1153, 1154, 1155, 1280, 1281, 1282, 1283, 1408, 1409, 1410, 1411,
    1536, 1537, 1538, 1539, 1664, 1665, 1666, 1667, 1792, 1793, 1794, 1795, 1920, 1921, 1922, 1923,
    8, 9, 10, 136, 137, 138, 264, 265, 266, 392, 393, 394, 520, 521, 522, 648,
    649, 650, 776, 777, 778, 904, 905, 906, 2048, 2049, 2050, 2051, 2052, 2053, 2176, 2177,
    2178, 2179, 2180, 2181, 2304, 2305, 2306, 2307, 2308, 2309, 2432, 2433, 2434, 2435, 2436, 2437,
    2560, 2561, 2562, 2563, 2564, 2565, 2688, 2689, 2690, 2691, 2692, 2693, 2816, 2817, 2818, 2819,
    2820, 2821, 2944, 2945, 2946, 2947, 2948, 2949, 0, 1, 2, 128, 129, 130, 256, 257,
    258, 384, 385, 386, 512, 513, 514, 640, 641, 642, 768, 769, 770, 896, 897, 898,
};

typedef short bf16x8 __attribute__((ext_vector_type(8)));
typedef short s16x4 __attribute__((ext_vector_type(4)));
typedef float f32x16 __attribute__((ext_vector_type(16)));
constexpr int AT_KST = 144, AT_VST = 192;
constexpr int AT_KBUF = 64 * AT_KST, AT_VBUF = 64 * AT_VST;
constexpr int AT_K0 = 0, AT_V0 = 2 * AT_KBUF;
constexpr int AT_KBUF2 = 128 * AT_KST, AT_VBUF2 = 128 * AT_VST, AT_V02 = 2 * AT_KBUF2, AT_MISC = AT_V02 + 2 * AT_VBUF2;
constexpr float AT_NEG = -1e30f;
constexpr int CW_ATTQ = 8192;

__device__ __forceinline__ s16x4 at_vtr(LAS const unsigned char* p) { return __builtin_bit_cast(s16x4, __builtin_amdgcn_ds_read_tr16_b64_v4i16((LAS s16x4*)p)); }
__device__ __forceinline__ unsigned at_cvt(float lo, float hi) { unsigned r; asm("v_cvt_pk_bf16_f32 %0, %1, %2" : "=v"(r) : "v"(lo), "v"(hi)); return r; }

template <int NSTEP, int Q0>
__device__ __forceinline__ void at_qk(f32x16 (&S)[2], LAS const unsigned char* kl, const bf16x8 (&qf)[4]) {
#pragma unroll
    for (int kb = 0; kb < 2; ++kb) {
        f32x16 acc = {};
#pragma unroll
        for (int s = 0; s < NSTEP; ++s) { const bf16x8 a = *(LAS const bf16x8*)(kl + kb * 32 * AT_KST + s * 32); acc = __builtin_amdgcn_mfma_f32_32x32x16_bf16(a, qf[Q0 + s], acc, 0, 0, 0); }
        S[kb] = acc;
    }
}
__device__ __forceinline__ void at_softmax(f32x16 (&S)[2], float& m, float& l, f32x16 (&O)[2]) {
    (void)m; (void)O;
    float s0 = 0.f, s1 = 0.f;
#pragma unroll
    for (int i = 0; i < 16; ++i) { const float p0 = __builtin_amdgcn_exp2f(S[0][i]), p1 = __builtin_amdgcn_exp2f(S[1][i]); S[0][i] = p0; S[1][i] = p1; s0 += p0; s1 += p1; }
    l += s0 + s1;
}
template <bool LANEMASK = false>
__device__ __forceinline__ void at_pv(f32x16 (&O)[2], const f32x16 (&S)[2], LAS const unsigned char* vl, unsigned pmask = ~0u) {
#pragma unroll
    for (int ks = 0; ks < 4; ++ks) {
        const int kb = ks >> 1, s8 = (ks & 1) * 8;
        u32x4 pw; pw.x = at_cvt(S[kb][s8], S[kb][s8 + 1]); pw.y = at_cvt(S[kb][s8 + 2], S[kb][s8 + 3]); pw.z = at_cvt(S[kb][s8 + 4], S[kb][s8 + 5]); pw.w = at_cvt(S[kb][s8 + 6], S[kb][s8 + 7]);
        if (LANEMASK) { pw.x &= pmask; pw.y &= pmask; pw.z &= pmask; pw.w &= pmask; }
        const bf16x8 pf = __builtin_bit_cast(bf16x8, pw);
#pragma unroll
        for (int db = 0; db < 2; ++db) {
            const s16x4 lo = at_vtr(vl + (ks * 16) * AT_VST + db * 64), hi = at_vtr(vl + (ks * 16 + 8) * AT_VST + db * 64);
            const bf16x8 vf = {lo[0], lo[1], lo[2], lo[3], hi[0], hi[1], hi[2], hi[3]};
            O[db] = __builtin_amdgcn_mfma_f32_32x32x16_bf16(vf, pf, O[db], 0, 0, 0);
        }
    }
}
__device__ __forceinline__ void at_mask_causal(f32x16 (&S)[2], int qrel, int h) {
#pragma unroll
    for (int kb = 0; kb < 2; ++kb)
#pragma unroll
        for (int i = 0; i < 16; ++i) { const int kvt = kb * 32 + (i & 3) + 8 * (i >> 2) + 4 * h; if (kvt > qrel) S[kb][i] = AT_NEG; }
}
__device__ __forceinline__ void at_mask_bits(f32x16 (&S)[2], unsigned long long w, int h) {
    const unsigned long long ws = w >> (4 * h); const unsigned b0 = (unsigned)ws, b1 = (unsigned)(ws >> 32);
#pragma unroll
    for (int i = 0; i < 16; ++i) { const int sh = (i & 3) + 8 * (i >> 2);
        const float p0 = S[0][i], p1 = S[1][i];
        S[0][i] = __builtin_bit_cast(float, __builtin_bit_cast(unsigned, p0) & (unsigned)__builtin_amdgcn_sbfe(b0, sh, 1));
        S[1][i] = __builtin_bit_cast(float, __builtin_bit_cast(unsigned, p1) & (unsigned)__builtin_amdgcn_sbfe(b1, sh, 1)); }
}
__device__ __forceinline__ void at_exp(f32x16 (&S)[2]) {
#pragma unroll
    for (int i = 0; i < 16; ++i) { S[0][i] = __builtin_amdgcn_exp2f(S[0][i]); S[1][i] = __builtin_amdgcn_exp2f(S[1][i]); }
}
__device__ __forceinline__ void at_rowsum(const f32x16 (&S)[2], float& l) {
    float s0 = 0.f, s1 = 0.f;
#pragma unroll
    for (int i = 0; i < 16; ++i) { s0 += S[0][i]; s1 += S[1][i]; }
    l += s0 + s1;
}
__device__ __forceinline__ void at_store(const f32x16 (&O)[2], float rl, bf16* yrow, int h) {
#pragma unroll
    for (int db = 0; db < 2; ++db)
#pragma unroll
        for (int g4 = 0; g4 < 4; ++g4) {
            const unsigned long long w = (unsigned long long)at_cvt(O[db][4 * g4] * rl, O[db][4 * g4 + 1] * rl) | ((unsigned long long)at_cvt(O[db][4 * g4 + 2] * rl, O[db][4 * g4 + 3] * rl) << 32);
            *(unsigned long long*)(yrow + db * 32 + 8 * g4 + 4 * h) = w;
        }
}

__device__ __forceinline__ void at_kload(bf16x8 (&kf)[8], LAS const unsigned char* kl) {
#pragma unroll
    for (int kb = 0; kb < 2; ++kb)
#pragma unroll
        for (int s = 0; s < 4; ++s) kf[kb * 4 + s] = *(LAS const bf16x8*)(kl + kb * 32 * AT_KST + s * 32);
}
__device__ __forceinline__ void at_qk_regs(f32x16 (&S)[2], const bf16x8 (&kf)[8], const bf16x8 (&qf)[4]) {
#pragma unroll
    for (int kb = 0; kb < 2; ++kb) {
        f32x16 acc = {};
#pragma unroll
        for (int s = 0; s < 4; ++s) acc = __builtin_amdgcn_mfma_f32_32x32x16_bf16(kf[kb * 4 + s], qf[s], acc, 0, 0, 0);
        S[kb] = acc;
    }
}
__device__ __forceinline__ void at_qk_half(f32x16& S, LAS const unsigned char* kl, const bf16x8 (&qf)[4]) {
    bf16x8 kf[4];
#pragma unroll
    for (int s = 0; s < 4; ++s) kf[s] = *(LAS const bf16x8*)(kl + s * 32);
    __builtin_amdgcn_sched_barrier(0);
    f32x16 acc = {};
#pragma unroll
    for (int s = 0; s < 4; ++s) acc = __builtin_amdgcn_mfma_f32_32x32x16_bf16(kf[s], qf[s], acc, 0, 0, 0);
    S = acc;
}
__device__ __forceinline__ void at_vload(s16x4 (&vlo)[8], s16x4 (&vhi)[8], LAS const unsigned char* vl) {
#pragma unroll
    for (int ks = 0; ks < 4; ++ks)
#pragma unroll
        for (int db = 0; db < 2; ++db) { vlo[ks * 2 + db] = at_vtr(vl + (ks * 16) * AT_VST + db * 64); vhi[ks * 2 + db] = at_vtr(vl + (ks * 16 + 8) * AT_VST + db * 64); }
}
template <bool LANEMASK = false>
__device__ __forceinline__ void at_pv_regs(f32x16 (&O)[2], const f32x16 (&S)[2], const s16x4 (&vlo)[8], const s16x4 (&vhi)[8], unsigned pmask = ~0u) {
#pragma unroll
    for (int ks = 0; ks < 4; ++ks) {
        const int kb = ks >> 1, s8 = (ks & 1) * 8;
        u32x4 pw; pw.x = at_cvt(S[kb][s8], S[kb][s8 + 1]); pw.y = at_cvt(S[kb][s8 + 2], S[kb][s8 + 3]); pw.z = at_cvt(S[kb][s8 + 4], S[kb][s8 + 5]); pw.w = at_cvt(S[kb][s8 + 6], S[kb][s8 + 7]);
        if (LANEMASK) { pw.x &= pmask; pw.y &= pmask; pw.z &= pmask; pw.w &= pmask; }
        const bf16x8 pf = __builtin_bit_cast(bf16x8, pw);
#pragma unroll
        for (int db = 0; db < 2; ++db) {
            const s16x4 lo = vlo[ks * 2 + db], hi = vhi[ks * 2 + db];
            const bf16x8 vf = {lo[0], lo[1], lo[2], lo[3], hi[0], hi[1], hi[2], hi[3]};
            O[db] = __builtin_amdgcn_mfma_f32_32x32x16_bf16(vf, pf, O[db], 0, 0, 0);
        }
    }
}
struct AtCtx { const bf16* PROJ; const unsigned long long* MASKA; const float* KMEAN; bf16* Y; const float* dsub; float lam, lam_init; };

template <int KIND>
__device__ __forceinline__ void at_unit(const AtCtx& C, int b, int x, int y, LAS unsigned char* lds, int tid, int lane, int wave) {
    const int r = lane & 31, h = lane >> 5;
    int qw, kcol, vcol, NT;
    int qcol0, qcol1 = 0, ycol;
    if (KIND == 0) { const int head = 2 * y + (wave >> 2); qw = 128 * x + 32 * (wave & 3); kcol = C_KA; vcol = C_VA; NT = 2 * (x + 1); qcol0 = C_QA + 64 * head; ycol = 64 * head; }
    else if (KIND == 1) { qw = 256 * x + 32 * wave; kcol = C_KB + 64 * y; vcol = C_VB + 64 * y; NT = 4 * (x + 1); qcol0 = C_QB + 64 * y; qcol1 = qcol0 + 32; ycol = 384 + 64 * y; }
    else { qw = 256 * x + 32 * wave; kcol = C_KC + 64 * y; vcol = C_VC + 64 * y; NT = 4 * (x + 1); qcol0 = C_QC + 64 * y; ycol = 640 + 64 * y; }
    const int q = qw + r;
    const unsigned mrow = (unsigned)(b * SEQ + q);
    const bf16* kvbase = C.PROJ + (size_t)b * SEQ * NP;
    bf16x8 qf[4];
    if (KIND == 1) {
#pragma unroll
        for (int s = 0; s < 2; ++s) { qf[s] = *(const bf16x8*)(C.PROJ + (size_t)mrow * NP + qcol0 + 16 * s + 8 * h); qf[2 + s] = *(const bf16x8*)(C.PROJ + (size_t)mrow * NP + qcol1 + 16 * s + 8 * h); }
    } else {
#pragma unroll
        for (int s = 0; s < 4; ++s) qf[s] = *(const bf16x8*)(C.PROJ + (size_t)mrow * NP + qcol0 + 16 * s + 8 * h);
    }
    unsigned selb = 0u;
    f32x16 O0[2], O1[2];
    float m0 = AT_NEG, l0 = 0.f, m1 = AT_NEG, l1 = 0.f;
#pragma unroll
    for (int d = 0; d < 2; ++d) { O0[d] = (f32x16){}; O1[d] = (f32x16){}; }
    const int srow = tid >> 3, sch = tid & 7;
    const unsigned kofs = (unsigned)(srow * NP + kcol + 8 * sch), vofs = (unsigned)(srow * NP + vcol + 8 * sch);
#define kg (kvbase + kofs)
#define vg (kvbase + vofs)
    LAS unsigned char* kst = lds + AT_K0 + srow * AT_KST + sch * 16;
    LAS unsigned char* vst = lds + AT_V0 + srow * AT_VST + sch * 16;
    LAS const unsigned char* kl = lds + AT_K0 + r * AT_KST + h * 16;
    LAS const unsigned char* vl = lds + AT_V0 + (4 * h + ((lane & 15) >> 2)) * AT_VST + (16 * ((lane >> 4) & 1) + 4 * (lane & 3)) * 2;
    if (KIND == 1) {
        u32x4 kr0, vr0;
        kr0 = *(const u32x4*)kg; vr0 = *(const u32x4*)vg;
        *(LAS u32x4*)kst = kr0; *(LAS u32x4*)vst = vr0;
        __syncthreads();
#define AT_DSTEP(KL, VL, KW, VW, tt) do { const int t = (tt), cur = t & 1, kv0 = 64 * t; \
            if (t + 1 < NT) { KL = *(const u32x4*)(kg + (size_t)(kv0 + 64) * NP); VL = *(const u32x4*)(vg + (size_t)(kv0 + 64) * NP); } \
            if (kv0 <= qw + 31) { \
                LAS const unsigned char* klc = kl + cur * AT_KBUF; \
                LAS const unsigned char* vlc = vl + cur * AT_VBUF; \
                f32x16 S[2]; \
                at_qk<2, 0>(S, klc, qf); \
                if (kv0 + 63 > qw) at_mask_causal(S, q - kv0, h); \
                at_softmax(S, m0, l0, O0); \
                at_pv(O0, S, vlc); \
                at_qk<2, 2>(S, klc + 64, qf); \
                if (kv0 + 63 > qw) at_mask_causal(S, q - kv0, h); \
                at_softmax(S, m1, l1, O1); \
                at_pv(O1, S, vlc); \
            } \
            if (t + 1 < NT) { *(LAS u32x4*)(kst + (cur ^ 1) * AT_KBUF) = KW; *(LAS u32x4*)(vst + (cur ^ 1) * AT_VBUF) = VW; } \
            __syncthreads(); } while (0)
        for (int t2 = 0; t2 < NT; ++t2) { AT_DSTEP(kr0, vr0, kr0, vr0, t2); }
#undef AT_DSTEP
    } else {
        LAS unsigned char* kst2 = lds + AT_K0 + srow * AT_KST + sch * 16;
        LAS unsigned char* vst2 = lds + AT_V02 + srow * AT_VST + sch * 16;
        LAS const unsigned char* vl2 = lds + AT_V02 + (4 * h + ((lane & 15) >> 2)) * AT_VST + (16 * ((lane >> 4) & 1) + 4 * (lane & 3)) * 2;
        const int NS = NT >> 1;
        u32x4 ka = *(const u32x4*)kg, kb = *(const u32x4*)(kg + (size_t)64 * NP), va = *(const u32x4*)vg, vb = *(const u32x4*)(vg + (size_t)64 * NP);
        *(LAS u32x4*)kst2 = ka; *(LAS u32x4*)(kst2 + 64 * AT_KST) = kb; *(LAS u32x4*)vst2 = va; *(LAS u32x4*)(vst2 + 64 * AT_VST) = vb;
        unsigned long long mw0 = 0ull, mw1 = 0ull, mn0 = 0ull, mn1 = 0ull;
        if (KIND == 0) { mw0 = C.MASKA[(size_t)mrow * 32]; if (64 <= qw + 31) mw1 = C.MASKA[(size_t)mrow * 32 + 1]; }
        LAS float* kmL = (LAS float*)(lds + AT_MISC + 256);
        if (KIND == 2) kmL[tid] = C.KMEAN[(size_t)(b * 6 + y) * 512 + tid];
        __syncthreads();
        if (KIND == 2) {
            const int npast = x;
            float gt[8];
#pragma unroll
            for (int n = 0; n < 8; ++n) {
                float a = 0.f;
#pragma unroll
                for (int s = 0; s < 4; ++s) {
                    const f32x4 k0 = *(const LAS f32x4*)(kmL + n * 64 + 16 * s + 8 * h), k1 = *(const LAS f32x4*)(kmL + n * 64 + 16 * s + 8 * h + 4);
                    const u32x4 qw4 = __builtin_bit_cast(u32x4, qf[s]);
                    a += bflo(qw4.x) * k0.x + bfhi(qw4.x) * k0.y + bflo(qw4.y) * k0.z + bfhi(qw4.y) * k0.w + bflo(qw4.z) * k1.x + bfhi(qw4.z) * k1.y + bflo(qw4.w) * k1.z + bfhi(qw4.w) * k1.w;
                }
                a += __shfl_xor(a, 32);
                asm volatile("" : "+v"(a) :: "memory");
                gt[n] = a;
            }
#pragma unroll
            for (int n = 0; n < 8; ++n) { int rank = 0;
#pragma unroll
                for (int j = 0; j < 8; ++j) rank += (j < npast && (gt[j] > gt[n] || (gt[j] == gt[n] && j < n))) ? 1 : 0;
                if (n < npast && rank < 3) selb |= 1u << n; }
        }
        for (int st = 0; st < NS; ++st) {
            const int cur = st & 1;
            if (st + 1 < NS) { const size_t go = (size_t)(128 * (st + 1)) * NP;
                ka = *(const u32x4*)(kg + go); kb = *(const u32x4*)(kg + go + (size_t)64 * NP); va = *(const u32x4*)(vg + go); vb = *(const u32x4*)(vg + go + (size_t)64 * NP);
                if (KIND == 0) { mn0 = 0ull; mn1 = 0ull; if (128 * (st + 1) <= qw + 31) mn0 = C.MASKA[(size_t)mrow * 32 + 2 * st + 2]; if (128 * (st + 1) + 64 <= qw + 31) mn1 = C.MASKA[(size_t)mrow * 32 + 2 * st + 3]; } }
#pragma unroll
            for (int sub = 0; sub < 2; ++sub) {
                const int t_ = 2 * st + sub, kv0 = 64 * t_;
                bool rel = kv0 <= qw + 31, lsel = true;
                if (KIND == 2) { const int n_ = t_ >> 2; if (n_ < x) { lsel = (selb >> n_) & 1u; rel = rel && __any(lsel); } }
                if (rel) {
                    LAS const unsigned char* klc = kl + cur * AT_KBUF2 + sub * 64 * AT_KST;
                    LAS const unsigned char* vlc = vl2 + cur * AT_VBUF2 + sub * 64 * AT_VST;
                    f32x16 S[2];
                    at_qk_half(S[0], klc, qf); at_qk_half(S[1], klc + 32 * AT_KST, qf);
                    if (KIND == 2) { if ((t_ >> 2) >= x && kv0 + 63 > qw) at_mask_causal(S, q - kv0, h); }
                    at_exp(S);
                    if (KIND == 0) at_mask_bits(S, sub ? mw1 : mw0, h);
                    if (KIND == 2 && (t_ >> 2) < x) { float sm_ = 0.f; at_rowsum(S, sm_); l0 += lsel ? sm_ : 0.f; at_pv<true>(O0, S, vlc, lsel ? ~0u : 0u); }
                    else { at_rowsum(S, l0); at_pv(O0, S, vlc); }
                }
            }
            if (st + 1 < NS) { LAS unsigned char* kd = kst2 + (cur ^ 1) * AT_KBUF2; LAS unsigned char* vd = vst2 + (cur ^ 1) * AT_VBUF2;
                *(LAS u32x4*)kd = ka; *(LAS u32x4*)(kd + 64 * AT_KST) = kb; *(LAS u32x4*)vd = va; *(LAS u32x4*)(vd + 64 * AT_VST) = vb; }
            __syncthreads();
            mw0 = mn0; mw1 = mn1;
        }
    }
#undef kg
#undef vg
    l0 += __shfl_xor(l0, 32);
    bf16* yrow = C.Y + (size_t)mrow * DM + ycol;
    if (KIND == 1) {
        l1 += __shfl_xor(l1, 32);
        const float r0 = 1.f / l0, r1 = C.lam / l1;
        float ss = 0.f;
#pragma unroll
        for (int d = 0; d < 2; ++d)
#pragma unroll
            for (int i = 0; i < 16; ++i) { const float o = O0[d][i] * r0 - O1[d][i] * r1; O0[d][i] = o; ss += o * o; }
        ss += __shfl_xor(ss, 32);
        const float rs = (1.f / sqrtf(ss * (1.f / 64.f) + 1e-5f)) * (1.f - C.lam_init);
#pragma unroll
        for (int d = 0; d < 2; ++d)
#pragma unroll
            for (int g4 = 0; g4 < 4; ++g4) { const f32x4 gs = *(const f32x4*)(C.dsub + d * 32 + 8 * g4 + 4 * h);
                O0[d][4 * g4] *= gs.x; O0[d][4 * g4 + 1] *= gs.y; O0[d][4 * g4 + 2] *= gs.z; O0[d][4 * g4 + 3] *= gs.w; }
        at_store(O0, rs, yrow, h);
    } else {
        at_store(O0, 1.f / l0, yrow, h);
    }
}
__device__ __forceinline__ void phase_attn_mfma(const AtCtx& C, unsigned* qhead, LAS unsigned char* lds, int tid, int lane, int wave) {
    LAS int* uq = (LAS int*)(lds + AT_MISC);
    for (;;) {
        if (tid == 0) uq[0] = (int)__hip_atomic_fetch_add(qhead, 1u, __ATOMIC_RELAXED, __HIP_MEMORY_SCOPE_AGENT);
        __syncthreads();
        const int ui = __builtin_amdgcn_readfirstlane(uq[0]);
        __syncthreads();
        if (ui >= 1024 * (1 + PROBE_ATT2)) break;
        const unsigned e = ATT_UNITS[ui & 1023];
        const int kind = e >> 10, b = (e >> 7) & 7, x = (e >> 3) & 15, y = e & 7;
        int tid_u = tid; asm volatile("" : "+v"(tid_u));
        const int lane_u = tid_u & 63;
        if (kind == 0) at_unit<0>(C, b, x, y, lds, tid_u, lane_u, wave);
        else if (kind == 1) at_unit<1>(C, b, x, y, lds, tid_u, lane_u, wave);
        else at_unit<2>(C, b, x, y, lds, tid_u, lane_u, wave);
    }
}

__device__ __forceinline__ ArgsP get_args() { ArgsP p = (ArgsP)__builtin_amdgcn_kernarg_segment_ptr(); asm volatile("" : "+s"(p)); return p; }
#define SITE_VARS ArgsP AP = get_args(); unsigned char* ws = AP->ws; int G = gridDim.x, wg = blockIdx.x; asm volatile("" : "+s"(G), "+s"(wg)); int tid = threadIdx.x; asm volatile("" : "+v"(tid)); \
    const int lane = tid & 63, wave = __builtin_amdgcn_readfirstlane(tid >> 6), gw = wg * NWAVES + wave, ngw = G * NWAVES; (void)gw; (void)ngw; (void)ws; (void)lane;

__global__ void __launch_bounds__(NTHR, 2) mega_fwd(Args Aarg) {
    extern __shared__ __attribute__((aligned(16))) unsigned char lds_raw[];
    LAS unsigned char* lds = (LAS unsigned char*)lds_raw;
    volatile LAS unsigned* MISC = (volatile LAS unsigned*)(lds + MISC_OFF);
    if (threadIdx.x < 32) MISC[threadIdx.x] = 0u;
    __syncthreads();
    const int lo = Aarg.ph_lo, hi = Aarg.ph_hi;
    XcdBarrier bar; bar.bar = (unsigned*)(Aarg.ws + WS_CTL) + CW_BAR; bar.x = 0; bar.st = nullptr;
    if (hi - lo > 1) bar = xcd_barrier_post((unsigned*)(Aarg.ws + WS_CTL) + CW_BAR, MISC + 8);
    int ph = 0;
    const bool g256 = gridDim.x == 256;
#define PH_BEGIN if (ph >= lo && ph < hi) { SITE_VARS
#define PH_END   if (ph + 1 < hi) { xcd_barrier(bar); if (PROBE_BAR) xcd_barrier(bar); } } ++ph;
#define WSP(type, off) ((type)(ws + (off)))
#define RFL(x) __builtin_amdgcn_readfirstlane(x)

    PH_BEGIN { for (int rep = 0; rep < 1 + PROBE_P0; ++rep) { p0_prologue(AP, lds, wg, G, tid); __syncthreads(); } } PH_END

    for (int l = 0; l < DEPTH; ++l) {
        const float lam_init = 0.8f - 0.6f * expf(-0.3f * (float)l);
        const int j = l >> 1;
        if (!(g256 && (l & 1))) {
        PH_BEGIN { const float* mod_l = WSP(const float*, WS_MOD) + (size_t)l * NB * MODW;
            if (l == 2) {
                LAS int* tb = (LAS int*)(lds + MOE_TB_OFF); LAS int* cn = (LAS int*)(lds + MOE_CN_OFF);
                moe_tables(WSP(const unsigned*, WS_CTL) + CW_MOECNT, tb, cn, tid);
                phase_norm<true, false>(WSP(const void*, WS_X), WSP(bf16*, WS_X), AP->g_attn + (size_t)l * DM, mod_l, 0, DM, WSP(bf16*, WS_H), nullptr,
                                        WSP(const bf16*, WS_R), WSP(const int*, WS_ENTI), WSP(const float*, WS_ENTW), mod_l - (size_t)NB * MODW + 5 * DM, tb, gw, ngw, lane);
            } else {
                if (l == 0) phase_norm<false, false, false, false>(AP->x, nullptr, AP->g_attn + (size_t)l * DM, mod_l, 0, DM, WSP(bf16*, WS_H), nullptr, nullptr, nullptr, nullptr, nullptr, nullptr, gw, ngw, lane);
                else for (int rep = 0; rep < 1 + PROBE_NORM; ++rep) phase_norm<false, false>(WSP(const void*, WS_X), nullptr, AP->g_attn + (size_t)l * DM, mod_l, 0, DM, WSP(bf16*, WS_H), nullptr, nullptr, nullptr, nullptr, nullptr, nullptr, gw, ngw, lane);
            } } PH_END
        }
        PH_BEGIN {
            pg8::Gemm g{WSP(const bf16*, WS_H), WSP(const bf16*, WS_WIN + l * SZ_WIN), T, NP, DM}; pg8::StaticOrder S; S.init(T, NP, G, wg);
            pg8::EpiProj E{WSP(bf16*, WS_PROJ), WSP(float*, WS_WI), WSP(const float*, WS_ROPE), nullptr, nullptr};
            for (int rep = 0; rep < 1 + PROBE_PROJ; ++rep) { pg8::gemm_phase<pg8::EpiProj, pg8::StaticOrder, true, true>(lds, g, S, E, tid); __syncthreads(); }
        } PH_END
        PH_BEGIN {
            for (int rep = 0; rep < 1 + PROBE_IDX; ++rep)
            for (int it = wg; it < 1024 + 384; it += G) {
                if (it < 1024) { const int k = it / G, c = it % G; int u16 = it;
                    if (G == 256) { const int ti = c & 127; u16 = (2 * k + (c >> 7)) * 128 + ((k & 1) ? 127 - ti : ti); }
                    idx_unit16(u16, WSP(const bf16*, WS_PROJ), WSP(const float*, WS_WI), WSP(unsigned long long*, WS_MASKA), lds, tid, lane, wave); }
                else for (int rk = 0; rk < 1 + PROBE_KM; ++rk) kmean_unit(it - 1024, WSP(const bf16*, WS_PROJ), WSP(float*, WS_KMEAN), lds, tid);
            }
        } PH_END
        PH_BEGIN {
            const float* dl = AP->dlam + (size_t)l * 128;
            float sa = 0.f, sb = 0.f;
            if (lane < 32) { sa = dl[lane] * dl[32 + lane]; sb = dl[64 + lane] * dl[96 + lane]; }
            const float lam = expf(wave_sum(sa)) - expf(wave_sum(sb)) + lam_init;
            AtCtx C{WSP(const bf16*, WS_PROJ), WSP(const unsigned long long*, WS_MASKA), WSP(const float*, WS_KMEAN), WSP(bf16*, WS_Y), AP->dsub + (size_t)l * 64, lam, lam_init};
            if ((l & 1) && wg < NB) {
                const float* mod_l = WSP(const float*, WS_MOD) + (size_t)l * NB * MODW; const float* wrt = WSP(const float*, WS_WRT) + (size_t)j * NE * DM;
                LAS float* red = (LAS float*)lds;
                const float s0 = mod_l[(size_t)wg * MODW + 3 * DM + tid], s1 = mod_l[(size_t)wg * MODW + 3 * DM + tid + 512];
#pragma unroll
                for (int e = 0; e < 8; ++e) { const float v = wave_sum(s0 * wrt[e * DM + tid] + s1 * wrt[e * DM + tid + 512]); if (lane == 0) red[wave * 8 + e] = v; }
                __syncthreads();
                if (tid < 8) { float t = 0.f;
#pragma unroll
                    for (int w = 0; w < 8; ++w) t += red[w * 8 + tid];
                    WSP(float*, WS_RB8)[wg * 8 + tid] = t; }
                __syncthreads();
            }
            for (int rep = 0; rep < 1 + PROBE_ATT; ++rep) phase_attn_mfma(C, WSP(unsigned*, WS_CTL) + CW_ATTQ + 64 * l + 16 * rep, lds, tid, lane, wave);
        } PH_END
        PH_BEGIN { const float* mod_l = WSP(const float*, WS_MOD) + (size_t)l * NB * MODW;
            pg8::Gemm g{WSP(const bf16*, WS_Y), WSP(const bf16*, WS_WOUT + l * SZ_WOUT), T, DM, DM}; pg8::StaticOrder S; S.init(T, DM, G, wg);
            if (g256 && (l & 1) == 0) {
                unsigned* pc = WSP(unsigned*, WS_CTL) + CW_PANEL + 512 * l;
                if (l == 0) { pg8::EpiResidNorm<true, true> E{AP->x, WSP(bf16*, WS_X), mod_l + 2 * DM, AP->g_ffn + (size_t)l * DM, mod_l, 3 * DM, 4 * DM, WSP(void*, WS_H), WSP(float*, WS_SSP2), pc, F8_HSCALE, 1.f};
                    pg8::gemm_phase<pg8::EpiResidNorm<true, true>, pg8::StaticOrder, false, true>(lds, g, S, E, tid); }
                else { pg8::EpiResidNorm<false, true> E{WSP(const void*, WS_X), WSP(bf16*, WS_X), mod_l + 2 * DM, AP->g_ffn + (size_t)l * DM, mod_l, 3 * DM, 4 * DM, WSP(void*, WS_H), WSP(float*, WS_SSP2), pc, F8_HSCALE, 1.f};
                    pg8::gemm_phase<pg8::EpiResidNorm<false, true>, pg8::StaticOrder, false, true>(lds, g, S, E, tid); }
            }
            else if (g256) {
                pg8::EpiResidNormRoute E{WSP(const void*, WS_X), WSP(bf16*, WS_X), mod_l + 2 * DM, AP->g_ffn + (size_t)l * DM, mod_l, 3 * DM, 4 * DM, WSP(void*, WS_H), WSP(float*, WS_SSP2),
                                         WSP(unsigned*, WS_CTL) + CW_PANEL2 + 512 * j, F8_HSCALE, WSP(const float*, WS_WRT) + (size_t)j * NE * DM,
                                         WSP(int*, WS_LIST), WSP(int*, WS_ENTI), WSP(float*, WS_ENTW), WSP(unsigned*, WS_CTL) + CW_MOECNT + 64 * j, WSP(const float*, WS_RB8)};
                pg8::gemm_phase<pg8::EpiResidNormRoute, pg8::StaticOrder, false, true>(lds, g, S, E, tid);
            }
            else if (l == 0) { pg8::EpiResid<0, true> E{AP->x, WSP(bf16*, WS_X), mod_l + 2 * DM, nullptr, nullptr, nullptr, nullptr, 1.f};
                pg8::gemm_phase<pg8::EpiResid<0, true>, pg8::StaticOrder, true, true>(lds, g, S, E, tid); }
            else { pg8::EpiResid<0> E{WSP(const void*, WS_X), WSP(bf16*, WS_X), mod_l + 2 * DM, nullptr, nullptr, nullptr, nullptr, 1.f};
                pg8::gemm_phase<pg8::EpiResid<0>, pg8::StaticOrder, true, true>(lds, g, S, E, tid); }
        } PH_END
        if ((l & 1) == 0) {
            if (!g256) {
            PH_BEGIN { const float* mod_l = WSP(const float*, WS_MOD) + (size_t)l * NB * MODW;
                for (int rep = 0; rep < 1 + PROBE_NORM; ++rep) phase_norm<false, false, true>(WSP(const void*, WS_X), nullptr, AP->g_ffn + (size_t)l * DM, mod_l, 3 * DM, 4 * DM, WSP(bf16*, WS_H), nullptr, nullptr, nullptr, nullptr, nullptr, nullptr, gw, ngw, lane); } PH_END
            }
            PH_BEGIN {
                pg8::Gemm g{WSP(const bf16*, WS_H), WSP(const bf16*, WS_WGU + j * SZ_WGU8), T, 2 * DFF, DM / 2}; pg8::StaticOrder S; S.init(T, 2 * DFF, G, wg);
                pg8::EpiSwiGLU E{WSP(bf16*, WS_ACT), 0, 1.f / (F8_WSCALE * F8_HSCALE), nullptr, nullptr, F8_ASCALE};
                for (int rep = 0; rep < 1 + PROBE_DUP; ++rep) { pg8::gemm_phase<pg8::EpiSwiGLU, pg8::StaticOrder, true, true, true>(lds, g, S, E, tid); __syncthreads(); }
            } PH_END
            PH_BEGIN { const float* mod_l = WSP(const float*, WS_MOD) + (size_t)l * NB * MODW;
                pg8::Gemm g{WSP(const bf16*, WS_ACT), WSP(const bf16*, WS_WDN + j * SZ_WDN8), T, DM, DFF / 2}; pg8::StaticOrder S; S.init(T, DM, G, wg);
                if (g256) {
                    pg8::EpiResidNorm<false, false> E{WSP(const void*, WS_X), WSP(bf16*, WS_X), mod_l + 5 * DM, AP->g_attn + (size_t)(l + 1) * DM, mod_l + (size_t)NB * MODW, 0, DM, WSP(void*, WS_H), WSP(float*, WS_SSP2),
                                                      WSP(unsigned*, WS_CTL) + CW_PANEL + 512 * (l + 1), 1.f, 1.f / (F8_WSCALE * F8_ASCALE)};
                    pg8::gemm_phase<pg8::EpiResidNorm<false, false>, pg8::StaticOrder, false, true, true>(lds, g, S, E, tid);
                } else {
                pg8::EpiResid<0> E{WSP(const void*, WS_X), WSP(bf16*, WS_X), mod_l + 5 * DM, nullptr, nullptr, nullptr, nullptr, 1.f / (F8_WSCALE * F8_ASCALE)};
                pg8::gemm_phase<pg8::EpiResid<0>, pg8::StaticOrder, true, true, true>(lds, g, S, E, tid); }
            } PH_END
        } else {
            if (!g256) {
            PH_BEGIN { const float* mod_l = WSP(const float*, WS_MOD) + (size_t)l * NB * MODW;
                if (PROBE_ROUTE) phase_norm_route(WSP(const bf16*, WS_X), AP->g_ffn + (size_t)l * DM, mod_l, 3 * DM, 4 * DM, WSP(bf16*, WS_H), AP->w_router + (size_t)j * DM * NE,
                                 WSP(int*, WS_SSP1), WSP(int*, WS_SSP1 + 1024 * 1024), WSP(float*, WS_SSP1 + 2048 * 1024), WSP(unsigned*, WS_CTL) + CW_MOECNT + 64 * j + 32, lds, wg, G, tid, lane, wave);
                phase_norm_route(WSP(const bf16*, WS_X), AP->g_ffn + (size_t)l * DM, mod_l, 3 * DM, 4 * DM, WSP(bf16*, WS_H), AP->w_router + (size_t)j * DM * NE,
                                 WSP(int*, WS_LIST), WSP(int*, WS_ENTI), WSP(float*, WS_ENTW), WSP(unsigned*, WS_CTL) + CW_MOECNT + 64 * j, lds, wg, G, tid, lane, wave); } PH_END
            }
            PH_BEGIN {
                LAS int* tb = (LAS int*)(lds + MOE_TB_OFF); LAS int* cn = (LAS int*)(lds + MOE_CN_OFF);
                const int ntile = moe_tables(WSP(const unsigned*, WS_CTL) + CW_MOECNT + 64 * j, tb, cn, tid);
                for (int rep = 0; rep < 1 + PROBE_GATH; ++rep) phase_moe_gather(WSP(const bf16*, WS_H), WSP(bf16*, WS_HG), WSP(const int*, WS_LIST), tb, cn, ntile, gw, ngw, lane);
            } PH_END
            PH_BEGIN {
                LAS int* tb = (LAS int*)(lds + MOE_TB_OFF); LAS int* cn = (LAS int*)(lds + MOE_CN_OFF);
                const int ntile = moe_tables(WSP(const unsigned*, WS_CTL) + CW_MOECNT + 64 * j, tb, cn, tid);
                pg8::MoeOrder S{22, ntile, G, wg, RFL(tb[1]), RFL(tb[2]), RFL(tb[3]), RFL(tb[4]), RFL(tb[5]), RFL(tb[6]), RFL(tb[7])};
                pg8::Gemm g{WSP(const bf16*, WS_HG), WSP(const bf16*, WS_EGU + (size_t)(j * NE) * SZ_WGU8), ntile * 256, 2 * DFF, DM / 2};
                pg8::EpiSwiGLU E{WSP(bf16*, WS_ACTM), 22, 1.f / (F8_WSCALE * F8_HSCALE), nullptr, nullptr, F8_ASCALE};
                if (PROBE_MUPL) { pg8::MoeOrder S0{22, ntile, G, wg, 1 << 20, 1 << 20, 1 << 20, 1 << 20, 1 << 20, 1 << 20, 1 << 20};
                    pg8::gemm_phase<pg8::EpiSwiGLU, pg8::MoeOrder, true, true, true>(lds, g, S0, E, tid); __syncthreads(); }
                for (int rep = 0; rep < 1 + PROBE_MUP; ++rep) { pg8::gemm_phase<pg8::EpiSwiGLU, pg8::MoeOrder, true, true, true>(lds, g, S, E, tid); __syncthreads(); }
            } PH_END
            PH_BEGIN {
                LAS int* tb = (LAS int*)(lds + MOE_TB_OFF); LAS int* cn = (LAS int*)(lds + MOE_CN_OFF);
                const int ntile = moe_tables(WSP(const unsigned*, WS_CTL) + CW_MOECNT + 64 * j, tb, cn, tid);
                pg8::MoeOrder S{4, ntile, G, wg, RFL(tb[1]), RFL(tb[2]), RFL(tb[3]), RFL(tb[4]), RFL(tb[5]), RFL(tb[6]), RFL(tb[7])};
                pg8::Gemm g{WSP(const bf16*, WS_ACTM), WSP(const bf16*, WS_EDN + (size_t)(j * NE) * SZ_WDN8), ntile * 256, DM, DFF / 2};
                pg8::EpiStoreBf16 E{WSP(bf16*, WS_R), DM, 4, 1.f / (F8_WSCALE * F8_ASCALE)};
                for (int rep = 0; rep < 1 + PROBE_MDN; ++rep) { pg8::gemm_phase<pg8::EpiStoreBf16, pg8::MoeOrder, true, true, true>(lds, g, S, E, tid); __syncthreads(); }
            } PH_END
        }
    }
    PH_BEGIN {
        LAS int* tb = (LAS int*)(lds + MOE_TB_OFF); LAS int* cn = (LAS int*)(lds + MOE_CN_OFF);
        moe_tables(WSP(const unsigned*, WS_CTL) + CW_MOECNT + 64, tb, cn, tid);
        const float* mod3 = WSP(const float*, WS_MOD) + (size_t)3 * NB * MODW;
        for (int rep = 0; rep < 1 + PROBE_FIN; ++rep) phase_norm<true, true>(WSP(const void*, WS_X), nullptr, AP->g_final, nullptr, 0, 0, nullptr, AP->out,
                               WSP(const bf16*, WS_R), WSP(const int*, WS_ENTI), WSP(const float*, WS_ENTW), mod3 + 5 * DM, tb, gw, ngw, lane);
    } PH_END
#undef PH_BEGIN
#undef PH_END
}
constexpr int N_PHASES = 1 + DEPTH * 5 + 2 * 3 + 2 * 4 + 1;

#ifndef MK_MULTI
#define MK_MULTI 0
#endif
extern "C" void kernel_launch(void* const* d_in, const int* in_sizes, int n_in, void* d_out, int out_size, void* d_ws, size_t ws_size, hipStream_t stream) {
    static int grid = 0;
    if (grid == 0) {
        if (n_in != 19 || out_size != T * DM || ws_size < WS_END) { fprintf(stderr, "kernel_launch: unexpected problem (n_in %d, out %d, ws %zu)\n", n_in, out_size, ws_size); grid = -1; return; }
        int dev = 0, cus = 0;
        if (hipGetDevice(&dev) != hipSuccess || hipDeviceGetAttribute(&cus, hipDeviceAttributeMultiprocessorCount, dev) != hipSuccess) { grid = -1; return; }
        if (hipFuncSetAttribute((const void*)mega_fwd, hipFuncAttributeMaxDynamicSharedMemorySize, LDS_BYTES) != hipSuccess) { fprintf(stderr, "kernel_launch: hipFuncSetAttribute failed\n"); grid = -1; return; }
        int per_cu = 0;
        if (hipOccupancyMaxActiveBlocksPerMultiprocessor(&per_cu, (const void*)mega_fwd, NTHR, LDS_BYTES) != hipSuccess || per_cu < 1) fprintf(stderr, "kernel_launch: occupancy query reports %d\n", per_cu);
        (void)hipGetLastError();
        grid = cus;
    }
    if (grid < 0) return;
    (void)hipMemsetAsync((char*)d_ws + WS_CTL, 0, CTL_ZERO_BYTES, stream);
    Args a{};
    a.x = (const float*)d_in[0]; a.c = (const float*)d_in[1]; a.pos = (const int*)d_in[2]; a.w_in = (const float*)d_in[3]; a.w_out = (const float*)d_in[4];
    a.dlam = (const float*)d_in[5]; a.dsub = (const float*)d_in[6]; a.w_ada = (const float*)d_in[7]; a.b_ada = (const float*)d_in[8]; a.g_attn = (const float*)d_in[9]; a.g_ffn = (const float*)d_in[10];
    a.wg = (const float*)d_in[11]; a.wu = (const float*)d_in[12]; a.wd = (const float*)d_in[13]; a.w_router = (const float*)d_in[14]; a.eg = (const float*)d_in[15]; a.eu = (const float*)d_in[16]; a.ed = (const float*)d_in[17];
    a.g_final = (const float*)d_in[18]; a.out = (float*)d_out; a.ws = (unsigned char*)d_ws;
    const int nph = grid == 256 ? N_PHASES - 6 : N_PHASES;
#if MK_MULTI
    for (int p = 0; p < nph; ++p) { a.ph_lo = p; a.ph_hi = p + 1; hipLaunchKernelGGL(mega_fwd, dim3(grid), dim3(NTHR), LDS_BYTES, stream, a); }
#else
    a.ph_lo = 0; a.ph_hi = nph;
    hipLaunchKernelGGL(mega_fwd, dim3(grid), dim3(NTHR), LDS_BYTES, stream, a);
#endif
}
```
